# Optimizing an MI355X kernel written in HIP

```python
import math
import jax
import jax.numpy as jnp
from jax import lax
import numpy as np


D_MODEL = 1024
BATCH = 4
SEQ = 8192
DEPTH = 1
DEC_BATCH = 128
DEC_SEQ = 4
PAST_LEN = 16384
PAGE_SIZE = 128

EPS = 1e-6
ROPE_THETA = 10000.0
N_MEM = 256
WINDOW = 128
A_HD = 64
A_HEADS = D_MODEL // 128
A_KV = A_HEADS // 4
A_GROUP = A_HEADS // A_KV
A_SCALE = A_HD ** -0.5
B_HEADS = D_MODEL // 256
B_DK = 128
B_DV = 128
CONV_W = 4
GDN_CHUNK = 64
B_CONV_CH = B_HEADS * (2 * B_DK + B_DV)
C_HEADS = 4
C_HD = 128
N_BRANCH = 3
BRANCH_W = A_HEADS * A_HD
D_FF = ((8 * D_MODEL + 3 * 256 - 1) // (3 * 256)) * 256

kernel_name = 'hybrid_swa_sink_gdn_memxattn_step'


def _in_sizes():
    return [A_HEADS * A_HD, A_KV * A_HD, A_KV * A_HD,
            B_CONV_CH,
            B_HEADS, B_HEADS,
            B_HEADS * B_DV,
            C_HEADS * C_HD,
            N_BRANCH * D_MODEL]


def _split_points():
    return np.cumsum(_in_sizes())[:-1].tolist()


def _rms_norm(x, gain):
    xf = x.astype(jnp.float32)
    y = xf * lax.rsqrt(jnp.mean(xf * xf, axis=-1, keepdims=True) + EPS)
    return (y * gain.astype(jnp.float32)).astype(x.dtype)


def _l2norm(x):
    return x * lax.rsqrt(jnp.sum(x * x, axis=-1, keepdims=True) + EPS)


def _rope(x, pos):
    half = x.shape[-1] // 2
    inv = ROPE_THETA ** (-jnp.arange(half, dtype=jnp.float32) / half)
    ang = pos.astype(jnp.float32)[:, None] * inv[None, :]
    cos = jnp.cos(ang)[:, None, :]
    sin = jnp.sin(ang)[:, None, :]
    xf = x.astype(jnp.float32)
    x1, x2 = xf[..., :half], xf[..., half:]
    return jnp.concatenate([x1 * cos - x2 * sin, x2 * cos + x1 * sin], axis=-1).astype(x.dtype)


def _window_mask(qpos, kpos):
    d = qpos - kpos
    return (d >= 0) & (d < WINDOW) & (kpos >= 0)


def _sink_softmax(logits, sink):
    s = jnp.broadcast_to(sink.astype(jnp.float32).reshape(A_KV, A_GROUP, 1, 1), logits.shape[:-1] + (1,))
    p = jax.nn.softmax(jnp.concatenate([logits, s], axis=-1), axis=-1)
    return p[..., :-1]


def _swa_prompt(q, k, v, sink):
    Bsz, L = q.shape[:2]
    nb = L // WINDOW
    qb = q.reshape(Bsz, nb, WINDOW, A_KV, A_GROUP, A_HD)
    kb = k.reshape(Bsz, nb, WINDOW, A_KV, A_HD)
    vb = v.reshape(Bsz, nb, WINDOW, A_KV, A_HD)

    def with_prev(t):
        prev = jnp.concatenate([jnp.zeros_like(t[:, :1]), t[:, :-1]], axis=1)
        return jnp.concatenate([prev, t], axis=2)

    kk, vv = with_prev(kb), with_prev(vb)
    logits = jnp.einsum('bnqkgd,bnskd->bnkgqs', qb, kk, preferred_element_type=jnp.float32) * A_SCALE
    blk = jnp.arange(nb, dtype=jnp.int32)[:, None] * WINDOW
    qpos = blk + jnp.arange(WINDOW, dtype=jnp.int32)[None, :]
    kpos = blk - WINDOW + jnp.arange(2 * WINDOW, dtype=jnp.int32)[None, :]
    mask = _window_mask(qpos[:, :, None], kpos[:, None, :])
    logits = jnp.where(mask[None, :, None, None], logits, -jnp.inf)
    p = _sink_softmax(logits, sink)
    o = jnp.einsum('bnkgqs,bnskd->bnqkgd', p.astype(vv.dtype), vv)
    return o.reshape(Bsz, L, A_HEADS * A_HD)


def _swa_decode(q, k, v, win_k, win_v, sink, pos):
    Bsz, L = q.shape[:2]
    kk = jnp.concatenate([win_k.astype(k.dtype), k], axis=1)
    vv = jnp.concatenate([win_v.astype(v.dtype), v], axis=1)
    qg = q.reshape(Bsz, L, A_KV, A_GROUP, A_HD)
    logits = jnp.einsum('bqkgd,bskd->bkgqs', qg, kk, preferred_element_type=jnp.float32) * A_SCALE
    kpos = jnp.concatenate([pos[0] - WINDOW + jnp.arange(WINDOW, dtype=jnp.int32), pos])
    mask = _window_mask(pos[:, None], kpos[None, :])
    logits = jnp.where(mask, logits, -jnp.inf)
    p = _sink_softmax(logits, sink)
    o = jnp.einsum('bkgqs,bskd->bqkgd', p.astype(vv.dtype), vv)
    return o.reshape(Bsz, L, A_HEADS * A_HD), kk[:, -WINDOW:], vv[:, -WINDOW:]


def _gated_delta_rule(q, k, v, g, beta, state):
    Bsz, L, H, DK = q.shape
    DV = v.shape[-1]
    C = min(GDN_CHUNK, L)
    pad = (-L) % C
    N = (L + pad) // C

    def chunks(t):
        t = jnp.pad(t, [(0, 0), (0, pad)] + [(0, 0)] * (t.ndim - 2))
        t = t.reshape((Bsz, N, C) + t.shape[2:])
        return jnp.moveaxis(jnp.moveaxis(t, 1, 0), 3, 2)

    qc, kc, vc, gc, bc = chunks(q), chunks(k), chunks(v), chunks(g), chunks(beta)
    gcum = jnp.cumsum(gc, axis=-1)
    tri = jnp.tril(jnp.ones((C, C), dtype=bool))
    strict = jnp.tril(jnp.ones((C, C), dtype=bool), -1)
    decay = jnp.exp(jnp.where(tri, gcum[..., :, None] - gcum[..., None, :], -jnp.inf))
    kb = kc * bc[..., None]
    a = jnp.where(strict, jnp.einsum('nbhid,nbhjd->nbhij', kb, kc) * decay, 0.0)
    eye = jnp.eye(C, dtype=jnp.float32)
    rhs = jnp.concatenate([vc * bc[..., None], kb * jnp.exp(gcum)[..., None]], axis=-1)
    sol = lax.linalg.triangular_solve(a + eye, rhs, left_side=True, lower=True, unit_diagonal=True)
    u, w = sol[..., :DV], sol[..., DV:]
    qk = jnp.einsum('nbhid,nbhjd->nbhij', qc, kc) * decay

    def step(S, inp):
        q_i, k_i, u_i, w_i, qk_i, g_i = inp
        v_new = u_i - jnp.einsum('bhck,bhkv->bhcv', w_i, S)
        o_i = (jnp.einsum('bhck,bhkv->bhcv', q_i * jnp.exp(g_i)[..., None], S)
               + jnp.einsum('bhij,bhjv->bhiv', qk_i, v_new))
        g_last = g_i[..., -1]
        S = (S * jnp.exp(g_last)[..., None, None]
             + jnp.einsum('bhck,bhcv->bhkv', k_i * jnp.exp(g_last[..., None] - g_i)[..., None], v_new))
        return S, o_i

    S, o = lax.scan(step, state, (qc, kc, u, w, qk, gcum))
    o = jnp.swapaxes(jnp.moveaxis(o, 0, 1), 2, 3).reshape(Bsz, N * C, H, DV)[:, :L]
    return o, S


def _gdn_branch(qkv_raw, b_raw, a_raw, z, conv_hist, rec_state, conv_w, a_log, dt_bias, norm_w):
    Bsz, L, _ = qkv_raw.shape
    xx = jnp.concatenate([conv_hist.astype(qkv_raw.dtype), qkv_raw], axis=1)
    conv = sum(xx[:, i:i + L] * conv_w[i].astype(qkv_raw.dtype) for i in range(CONV_W))
    qkv = jax.nn.silu(conv).astype(jnp.float32)
    q, k, v = jnp.split(qkv, [B_HEADS * B_DK, 2 * B_HEADS * B_DK], axis=-1)
    q = _l2norm(q.reshape(Bsz, L, B_HEADS, B_DK)) * (B_DK ** -0.5)
    k = _l2norm(k.reshape(Bsz, L, B_HEADS, B_DK))
    v = v.reshape(Bsz, L, B_HEADS, B_DV)
    beta = jax.nn.sigmoid(b_raw.astype(jnp.float32))
    g = -jnp.exp(a_log.astype(jnp.float32)) * jax.nn.softplus(a_raw.astype(jnp.float32) + dt_bias.astype(jnp.float32))
    o, S = _gated_delta_rule(q, k, v, g, beta, rec_state.astype(jnp.float32))
    o = _rms_norm(o, norm_w) * jax.nn.silu(z.astype(jnp.float32).reshape(Bsz, L, B_HEADS, B_DV))
    return o.reshape(Bsz, L, B_HEADS * B_DV).astype(qkv_raw.dtype), xx[:, -(CONV_W - 1):], S


def _mem_kv(mem, ln_mem, w_mem_kv):
    Bsz, M, _ = mem.shape
    k, v = jnp.split(_rms_norm(mem, ln_mem) @ w_mem_kv, 2, axis=-1)
    return k.reshape(Bsz, M, C_HEADS, C_HD), v.reshape(Bsz, M, C_HEADS, C_HD)


def _mem_attend(q, mk, mv):
    logits = jnp.einsum('bqhd,bshd->bhqs', q, mk.astype(q.dtype), preferred_element_type=jnp.float32) * (C_HD ** -0.5)
    p = jax.nn.softmax(logits, axis=-1)
    o = jnp.einsum('bhqs,bshd->bqhd', p.astype(q.dtype), mv.astype(q.dtype))
    return o.reshape(q.shape[0], q.shape[1], C_HEADS * C_HD)


def _layer(x, pos, swa_fn, conv_hist, rec_state, mem_k, mem_v, p):
    Bsz, L, _ = x.shape
    h = _rms_norm(x, p['ln_mix_pre'])
    qa, ka, va, qkvb, bb, ab, zb, qc, gates = jnp.split(h @ p['w_in'], _split_points(), axis=-1)
    qa = _rope(qa.reshape(Bsz, L, A_HEADS, A_HD), pos)
    ka = _rope(ka.reshape(Bsz, L, A_KV, A_HD), pos)
    va = va.reshape(Bsz, L, A_KV, A_HD)
    oa, new_wk, new_wv = swa_fn(qa, ka, va)
    ob, new_conv, new_rec = _gdn_branch(qkvb, bb, ab, zb, conv_hist, rec_state, p['gdn_conv_w'],
                                        p['gdn_a_log'], p['gdn_dt_bias'], p['gdn_norm_w'])
    oc = _mem_attend(qc.reshape(Bsz, L, C_HEADS, C_HD), mem_k, mem_v)
    branches = jnp.stack([oa.astype(x.dtype), ob.astype(x.dtype), oc.astype(x.dtype)], axis=2)
    up = jnp.einsum('blnc,ncd->blnd', branches, p['w_branch'])
    gate = jax.nn.sigmoid(gates.reshape(Bsz, L, N_BRANCH, D_MODEL))
    mix = jnp.sum(gate * up, axis=2) @ p['w_out']
    x = x + _rms_norm(mix, p['ln_mix_post'])
    h = _rms_norm(x, p['ln_ffn_pre'])
    gt, uf = jnp.split(h @ p['w_ffn_in'], 2, axis=-1)
    f = (jax.nn.silu(gt) * uf) @ p['w_ffn_out']
    x = x + _rms_norm(f, p['ln_ffn_post'])
    return x, new_wk, new_wv, new_conv, new_rec


def setup_inputs(seed: int = 0) -> dict:
    key = jax.random.key(seed)
    ks = jax.random.split(key, 26)
    f32 = jnp.float32

    def nrm(k, shape, scale):
        return jax.random.normal(k, shape, f32) * scale

    def gain(k, n):
        return 1.0 + 0.05 * jax.random.normal(k, (n,), f32)

    n_in = int(sum(_in_sizes()))
    dt = jnp.exp(jax.random.uniform(ks[13], (B_HEADS,), f32, math.log(1e-3), math.log(1e-1)))
    return {
        'x_prompt': nrm(ks[0], (BATCH, SEQ, D_MODEL), 1.0),
        'x_sample': nrm(ks[1], (DEC_BATCH, DEC_SEQ, D_MODEL), 1.0),
        'mem_prompt': nrm(ks[2], (BATCH, N_MEM, D_MODEL), 1.0),
        'state_win_k': nrm(ks[3], (DEC_BATCH, WINDOW, A_KV, A_HD), 1.0),
        'state_win_v': nrm(ks[4], (DEC_BATCH, WINDOW, A_KV, A_HD), 1.0),
        'state_conv': nrm(ks[5], (DEC_BATCH, CONV_W - 1, B_CONV_CH), 1.0),
        'state_rec': nrm(ks[6], (DEC_BATCH, B_HEADS, B_DK, B_DV), 0.5),
        'cache_mem_k': nrm(ks[7], (DEC_BATCH, N_MEM, C_HEADS, C_HD), 1.0),
        'cache_mem_v': nrm(ks[8], (DEC_BATCH, N_MEM, C_HEADS, C_HD), 1.0),
        'ln_mix_pre': gain(ks[9], D_MODEL),
        'w_in': nrm(ks[10], (D_MODEL, n_in), D_MODEL ** -0.5),
        'attn_sink': nrm(ks[11], (A_HEADS,), 0.5),
        'gdn_conv_w': nrm(ks[12], (CONV_W, B_CONV_CH), CONV_W ** -0.5),
        'gdn_a_log': jnp.log(jax.random.uniform(ks[14], (B_HEADS,), f32, 1.0, 16.0)),
        'gdn_dt_bias': dt + jnp.log(-jnp.expm1(-dt)),
        'gdn_norm_w': gain(ks[15], B_DV),
        'ln_mem': gain(ks[16], D_MODEL),
        'w_mem_kv': nrm(ks[17], (D_MODEL, 2 * C_HEADS * C_HD), D_MODEL ** -0.5),
        'w_branch': nrm(ks[18], (N_BRANCH, BRANCH_W, D_MODEL), BRANCH_W ** -0.5),
        'w_out': nrm(ks[19], (D_MODEL, D_MODEL), D_MODEL ** -0.5),
        'ln_mix_post': gain(ks[20], D_MODEL),
        'ln_ffn_pre': gain(ks[21], D_MODEL),
        'w_ffn_in': nrm(ks[22], (D_MODEL, 2 * D_FF), D_MODEL ** -0.5),
        'w_ffn_out': nrm(ks[23], (D_FF, D_MODEL), D_FF ** -0.5),
        'ln_ffn_post': gain(ks[24], D_MODEL),
    }


def reference(x_prompt, x_sample, mem_prompt, state_win_k, state_win_v, state_conv, state_rec,
              cache_mem_k, cache_mem_v, ln_mix_pre, w_in, attn_sink, gdn_conv_w, gdn_a_log,
              gdn_dt_bias, gdn_norm_w, ln_mem, w_mem_kv, w_branch, w_out, ln_mix_post,
              ln_ffn_pre, w_ffn_in, w_ffn_out, ln_ffn_post):
    p = {'ln_mix_pre': ln_mix_pre, 'w_in': w_in, 'gdn_conv_w': gdn_conv_w, 'gdn_a_log': gdn_a_log,
         'gdn_dt_bias': gdn_dt_bias, 'gdn_norm_w': gdn_norm_w, 'w_branch': w_branch, 'w_out': w_out,
         'ln_mix_post': ln_mix_post, 'ln_ffn_pre': ln_ffn_pre, 'w_ffn_in': w_ffn_in,
         'w_ffn_out': w_ffn_out, 'ln_ffn_post': ln_ffn_post}

    Bp, Lp, _ = x_prompt.shape
    pos_p = jnp.arange(Lp, dtype=jnp.int32)
    mem_k_p, mem_v_p = _mem_kv(mem_prompt, ln_mem, w_mem_kv)

    def swa_prompt_fn(q, k, v):
        return _swa_prompt(q, k, v, attn_sink), k[:, -WINDOW:], v[:, -WINDOW:]

    conv0 = jnp.zeros((Bp, CONV_W - 1, B_CONV_CH), x_prompt.dtype)
    rec0 = jnp.zeros((Bp, B_HEADS, B_DK, B_DV), jnp.float32)
    y_prompt, wk_p, wv_p, conv_p, rec_p = _layer(x_prompt, pos_p, swa_prompt_fn, conv0, rec0,
                                                 mem_k_p, mem_v_p, p)

    pos_s = PAST_LEN + jnp.arange(x_sample.shape[1], dtype=jnp.int32)

    def swa_sample_fn(q, k, v):
        return _swa_decode(q, k, v, state_win_k, state_win_v, attn_sink, pos_s)

    y_sample, wk_s, wv_s, conv_s, rec_s = _layer(x_sample, pos_s, swa_sample_fn, state_conv, state_rec,
                                                 cache_mem_k, cache_mem_v, p)

    return (y_prompt, y_sample, wk_p, wv_p, conv_p, rec_p, mem_k_p, mem_v_p, wk_s, wv_s, conv_s, rec_s)
```

```cpp
#include <hip/hip_runtime.h>
#include <hip/hip_cooperative_groups.h>
#include <cstdio>
#include <cstdint>
namespace cg = cooperative_groups;

typedef unsigned short u16;
using bf16x8 = __attribute__((ext_vector_type(8))) short;
using bf16x4 = __attribute__((ext_vector_type(4))) short;
using f32x4 = __attribute__((ext_vector_type(4))) float;
#define DEV __device__ __forceinline__

#define REP_MASK 0
#ifndef N_LAUNCH_MODE
#define N_LAUNCH_MODE 1
#endif

constexpr int TP = 32768, TSMP = 512, TT = 33280, DM = 1024;
constexpr int SEQ = 8192;
constexpr int NP1 = 3328;
constexpr int C_QA = 0, C_KA = 512, C_VA = 640, C_QKVB = 768, C_ZB = 2304, C_QC = 2816;
constexpr int NGATE = 3072;
constexpr int DFF = 2816;
constexpr int WIN_LD = 6408;
constexpr float EPS = 1e-6f;

constexpr size_t OFF_Y = 0;
constexpr size_t OFF_WKP = (size_t)TT * DM;
constexpr size_t OFF_WVP = OFF_WKP + 65536;
constexpr size_t OFF_CVP = OFF_WVP + 65536;
constexpr size_t OFF_RECP = OFF_CVP + 18432;
constexpr size_t OFF_MKP = OFF_RECP + 262144;
constexpr size_t OFF_MVP = OFF_MKP + 524288;
constexpr size_t OFF_WKS = OFF_MVP + 524288;
constexpr size_t OFF_WVS = OFF_WKS + 2097152;
constexpr size_t OFF_CVS = OFF_WVS + 2097152;
constexpr size_t OFF_RECS = OFF_CVS + 589824;
constexpr size_t OUT_TOTAL = OFF_RECS + 8388608;

constexpr size_t al256(size_t x) { return (x + 255) & ~(size_t)255; }
constexpr size_t WS_WIN = 0;
constexpr size_t WS_WMEM = WS_WIN + (size_t)6400 * 1024 * 2;
constexpr size_t WS_WBR = WS_WMEM + (size_t)1024 * 1024 * 2;
constexpr size_t WS_WOUT = WS_WBR + (size_t)3 * 1024 * 512 * 2;
constexpr size_t WS_WF1 = WS_WOUT + (size_t)1024 * 1024 * 2;
constexpr size_t WS_WF2 = WS_WF1 + (size_t)5632 * 1024 * 2;
constexpr size_t WS_H = WS_WF2 + (size_t)1024 * 2816 * 2;
constexpr size_t WS_P1 = WS_H + (size_t)TT * 1024 * 2;
constexpr size_t WS_GS = WS_P1 + (size_t)TT * NP1 * 2;
constexpr size_t GS_ITEM = 36864;
constexpr size_t WS_MISC = WS_GS + (size_t)2048 * GS_ITEM * 2;
constexpr size_t WS_BA = WS_MISC;
constexpr size_t WS_ROPE = WS_BA + (size_t)TT * 8 * 4;
constexpr size_t WS_HMEM = al256(WS_ROPE + (size_t)8196 * 32 * 8);
constexpr size_t WS_MEMKV = WS_HMEM + (size_t)1024 * 1024 * 2;
constexpr size_t WS_GAM = WS_MEMKV + (size_t)1024 * 1024 * 2;
constexpr size_t WS_SSQ = WS_GAM + 2048 * 4;
constexpr size_t WS_GSMP = WS_SSQ + (size_t)TP * 4 * 8 * 4;
constexpr size_t WS_CTR = WS_GSMP + (size_t)TSMP * NGATE * 2;
constexpr size_t WS_ACC6 = WS_CTR + 256;
constexpr size_t WS_ACC9 = WS_ACC6 + (size_t)4 * TSMP * DM * 4;
constexpr size_t WS_END = WS_ACC9 + (size_t)11 * TSMP * DM * 4;
constexpr size_t WS_STASH = WS_GS;
constexpr size_t WS_MIX = WS_GS + (size_t)TT * 1024 * 2;
constexpr size_t WS_F2 = WS_GS;

constexpr int LDS_BYTES = 160 * 1024;

struct Params {
  const float *x_prompt, *x_sample, *mem_prompt, *state_win_k, *state_win_v, *state_conv, *state_rec, *cache_mem_k, *cache_mem_v;
  const float *ln_mix_pre, *w_in, *attn_sink, *gdn_conv_w, *gdn_a_log, *gdn_dt_bias, *gdn_norm_w, *ln_mem, *w_mem_kv, *w_branch,
      *w_out, *ln_mix_post, *ln_ffn_pre, *w_ffn_in, *w_ffn_out, *ln_ffn_post;
  float* out;
  char* ws;
  long long ph_lo, ph_hi;
};

extern __shared__ __attribute__((aligned(16))) char smem[];

__device__ const float ROPE_INV[32] = {
    1.0f, 0.7498942093324559f, 0.5623413251903491f, 0.4216965034285822f, 0.31622776601683794f, 0.23713737056616552f,
    0.1778279410038923f, 0.1333521432163324f, 0.1f, 0.07498942093324558f, 0.05623413251903491f, 0.042169650342858224f,
    0.03162277660168379f, 0.023713737056616554f, 0.01778279410038923f, 0.01333521432163324f, 0.01f, 0.007498942093324558f,
    0.005623413251903491f, 0.004216965034285823f, 0.0031622776601683794f, 0.0023713737056616554f, 0.0017782794100389228f,
    0.001333521432163324f, 0.001f, 0.0007498942093324559f, 0.0005623413251903491f, 0.00042169650342858224f,
    0.00031622776601683794f, 0.00023713737056616554f, 0.00017782794100389227f, 0.0001333521432163324f};

typedef __bf16 hbf2 __attribute__((ext_vector_type(2)));
typedef float hf2 __attribute__((ext_vector_type(2)));
DEV unsigned pack2(float a, float b) {
  hf2 v = {a, b};
  hbf2 r = __builtin_convertvector(v, hbf2);
  return __builtin_bit_cast(unsigned, r);
}
DEV u16 f2bf(float f) { return (u16)(pack2(f, 0.f) & 0xffffu); }
DEV float bf2f(u16 h) { return __uint_as_float(((unsigned)h) << 16); }
DEV float row16_sum(float s) {
  s += __builtin_bit_cast(float, __builtin_amdgcn_update_dpp(0, __builtin_bit_cast(int, s), 0xB1, 0xf, 0xf, true));
  s += __builtin_bit_cast(float, __builtin_amdgcn_update_dpp(0, __builtin_bit_cast(int, s), 0x4E, 0xf, 0xf, true));
  s += __builtin_bit_cast(float, __builtin_amdgcn_update_dpp(0, __builtin_bit_cast(int, s), 0x124, 0xf, 0xf, true));
  s += __builtin_bit_cast(float, __builtin_amdgcn_update_dpp(0, __builtin_bit_cast(int, s), 0x128, 0xf, 0xf, true));
  return s;
}
DEV float bflo(unsigned w) { return __uint_as_float(w << 16); }
DEV float bfhi(unsigned w) { return __uint_as_float(w & 0xffff0000u); }
DEV void unpack8(uint4 v, float* o) {
  o[0] = bflo(v.x); o[1] = bfhi(v.x); o[2] = bflo(v.y); o[3] = bfhi(v.y);
  o[4] = bflo(v.z); o[5] = bfhi(v.z); o[6] = bflo(v.w); o[7] = bfhi(v.w);
}
DEV uint4 pack8(const float* o) {
  uint4 v; v.x = pack2(o[0], o[1]); v.y = pack2(o[2], o[3]); v.z = pack2(o[4], o[5]); v.w = pack2(o[6], o[7]);
  return v;
}
DEV float sigmoidf_(float x) { return __builtin_amdgcn_rcpf(1.f + __expf(-x)); }
DEV float siluf_(float x) { return x * __builtin_amdgcn_rcpf(1.f + __expf(-x)); }
DEV float wave_sum(float v) {
#pragma unroll
  for (int o = 32; o > 0; o >>= 1) v += __shfl_xor(v, o);
  return v;
}
DEV bf16x8 mk8(bf16x4 lo, bf16x4 hi) { return __builtin_shufflevector(lo, hi, 0, 1, 2, 3, 4, 5, 6, 7); }
DEV bf16x8 pack_acc2(f32x4 a, f32x4 b) {
  union { unsigned u[4]; bf16x8 v; } x;
  x.u[0] = pack2(a[0], a[1]); x.u[1] = pack2(a[2], a[3]); x.u[2] = pack2(b[0], b[1]); x.u[3] = pack2(b[2], b[3]);
  return x.v;
}
#define MFMA16(a, b, c) __builtin_amdgcn_mfma_f32_16x16x32_bf16((a), (b), (c), 0, 0, 0)

constexpr int G_BK = 64, G_HALF = 128, G_HT = G_HALF * G_BK;
DEV int lds_byte(int r, int c) {
  int st = (r >> 4) * 2 + (c >> 5), rr = r & 15, cc = c & 31, ob = rr * 64 + cc * 2;
  return st * 1024 + (ob ^ (((ob >> 9) & 1) << 5));
}
DEV void stage_rc(int b, int& R, int& C) {
  int st = b / 1024, sb = b % 1024, swz = sb ^ (((sb >> 9) & 1) << 5);
  R = (st >> 1) * 16 + swz / 64;
  C = (st & 1) * 32 + (swz % 64) / 2;
}

#define LAS __attribute__((address_space(3)))
struct GNext { const u16* A; const u16* B; int brow, bcol, valid; };
template <class Epi>
DEV void gemm_tile(const u16* __restrict__ A, int lda, const u16* __restrict__ Bt, int ldb, int K, int brow, int bcol, bool pre_issued, GNext nx, Epi epi) {
  LAS unsigned char* lds = (LAS unsigned char*)smem;
  constexpr int HTB = G_HT * 2;
  const int tid = threadIdx.x, wid = __builtin_amdgcn_readfirstlane(tid >> 6), lane = tid & 63, wr = wid >> 2, wc = wid & 3, fr = lane & 15, fq = lane >> 4;
  unsigned voffA[2], voffB[2];
#pragma unroll
  for (int i = 0; i < 2; ++i) {
    int R, C;
    stage_rc(tid * 16 + i * 8192, R, C);
    voffA[i] = (unsigned)(R * lda + C) * 2u;
    voffB[i] = (unsigned)(R * ldb + C) * 2u;
  }
  const size_t kstep = (size_t)(G_BK * 2);
  const size_t hstepA = (size_t)G_HALF * lda * 2, hstepB = (size_t)G_HALF * ldb * 2;
  const unsigned ldsw = (unsigned)wid * 1024u;
  const int aoff = lds_byte(wr * 64 + fr, fq * 8), boff = lds_byte(wc * 32 + fr, fq * 8);
  const char* cA = (const char*)A + (size_t)brow * lda * 2;
  const char* cB = (const char*)Bt + (size_t)bcol * ldb * 2;
#define SA(b, h) (((b)*2 + (h)) * HTB)
#define SB(b, h) ((4 + (b)*2 + (h)) * HTB)
#define STAGE(bufoff, gbase, voff)                                                                                      \
  do {                                                                                                                  \
    _Pragma("unroll") for (int _i = 0; _i < 2; ++_i) __builtin_amdgcn_global_load_lds(                                  \
        (const unsigned*)((const char*)(gbase) + (voff)[_i]), (LAS unsigned*)(lds + (bufoff) + ldsw + _i * 8192), 16, 0, 0); \
  } while (0)
#define LDA(dst, b, h)                                                                                                  \
  do {                                                                                                                  \
    _Pragma("unroll") for (int m = 0; m < 4; ++m) _Pragma("unroll") for (int k = 0; k < 2; ++k) dst[m][k] =             \
        *(const LAS bf16x8*)(lds + SA(b, h) + aoff + m * 2048 + k * 1024);                                              \
  } while (0)
#define LDB(dst, b, h)                                                                                                  \
  do {                                                                                                                  \
    _Pragma("unroll") for (int n = 0; n < 2; ++n) _Pragma("unroll") for (int k = 0; k < 2; ++k) dst[n][k] =             \
        *(const LAS bf16x8*)(lds + SB(b, h) + boff + n * 2048 + k * 1024);                                              \
  } while (0)
#define MMA(ai, bj, At_, Bt_)                                                                                           \
  do {                                                                                                                  \
    __builtin_amdgcn_s_setprio(1);                                                                                      \
    _Pragma("unroll") for (int m = 0; m < 4; ++m) _Pragma("unroll") for (int n = 0; n < 2; ++n)                         \
        _Pragma("unroll") for (int k = 0; k < 2; ++k) acc[ai][bj][m][n] = MFMA16(Bt_[n][k], At_[m][k], acc[ai][bj][m][n]); \
    __builtin_amdgcn_s_setprio(0);                                                                                      \
  } while (0)
#define WAIT_V(n) asm volatile("s_waitcnt vmcnt(" #n ")" ::: "memory")
#define WAIT_L(n) asm volatile("s_waitcnt lgkmcnt(" #n ")" ::: "memory")
#define BAR __builtin_amdgcn_s_barrier()
#define SCHED __builtin_amdgcn_sched_barrier(0)
  f32x4 acc[2][2][4][2];
#pragma unroll
  for (int a = 0; a < 2; ++a)
#pragma unroll
    for (int b = 0; b < 2; ++b)
#pragma unroll
      for (int m = 0; m < 4; ++m)
#pragma unroll
        for (int n = 0; n < 2; ++n) acc[a][b][m][n] = (f32x4){0.f, 0.f, 0.f, 0.f};
  bf16x8 At[4][2], B0[2][2], B1[2][2];
  const int nt = K / G_BK;
  if (!pre_issued) {
    WAIT_V(0);
    __syncthreads();
    STAGE(SB(0, 0), cB, voffB); STAGE(SA(0, 0), cA, voffA); STAGE(SB(0, 1), cB + hstepB, voffB); STAGE(SA(0, 1), cA + hstepA, voffA);
  }
  if (wr == 1) BAR;
  WAIT_V(4); BAR;
  STAGE(SB(1, 0), cB + kstep, voffB); STAGE(SA(1, 0), cA + kstep, voffA); STAGE(SB(1, 1), cB + hstepB + kstep, voffB);
  WAIT_V(6); BAR;
#pragma unroll 1
  for (int t = 0; t < nt - 2; t += 2) {
    const char* a1 = cA + (size_t)(t + 1) * kstep;
    const char* a2 = cA + (size_t)(t + 2) * kstep; const char* b2 = cB + (size_t)(t + 2) * kstep;
    const char* a3 = a2 + kstep; const char* b3 = b2 + kstep;
    LDB(B0, 0, 0); SCHED; LDA(At, 0, 0); STAGE(SA(1, 1), a1 + hstepA, voffA);
    WAIT_L(8); BAR; WAIT_L(0); MMA(0, 0, At, B0); BAR; SCHED;
    LDB(B1, 0, 1); STAGE(SB(0, 0), b2, voffB);
    BAR; WAIT_L(0); MMA(0, 1, At, B1); BAR;
    LDA(At, 0, 1); STAGE(SA(0, 0), a2, voffA);
    BAR; WAIT_L(0); MMA(1, 0, At, B0); BAR; SCHED;
    STAGE(SB(0, 1), b2 + hstepB, voffB);
    WAIT_V(6); BAR; MMA(1, 1, At, B1); BAR;
    LDB(B0, 1, 0); SCHED; LDA(At, 1, 0); STAGE(SA(0, 1), a2 + hstepA, voffA);
    WAIT_L(8); BAR; WAIT_L(0); MMA(0, 0, At, B0); BAR; SCHED;
    LDB(B1, 1, 1); STAGE(SB(1, 0), b3, voffB);
    BAR; WAIT_L(0); MMA(0, 1, At, B1); BAR;
    LDA(At, 1, 1); STAGE(SA(1, 0), a3, voffA);
    BAR; WAIT_L(0); MMA(1, 0, At, B0); BAR; SCHED;
    STAGE(SB(1, 1), b3 + hstepB, voffB);
    WAIT_V(6); BAR; MMA(1, 1, At, B1); BAR;
  }
  { const char* a1 = cA + (size_t)(nt - 1) * kstep;
    LDB(B0, 0, 0); LDA(At, 0, 0); STAGE(SA(1, 1), a1 + hstepA, voffA);
    BAR; WAIT_L(0); MMA(0, 0, At, B0); BAR;
    LDB(B1, 0, 1); BAR; WAIT_L(0); MMA(0, 1, At, B1); BAR;
    LDA(At, 0, 1); WAIT_V(4); BAR; WAIT_L(0); MMA(1, 0, At, B0); MMA(1, 1, At, B1); BAR; }
  { LDB(B0, 1, 0); LDA(At, 1, 0); WAIT_V(2); BAR; WAIT_L(0); MMA(0, 0, At, B0); BAR;
    LDB(B1, 1, 1); WAIT_V(0); BAR; WAIT_L(0); MMA(0, 1, At, B1); BAR;
    LDA(At, 1, 1); BAR; WAIT_L(0); MMA(1, 0, At, B0); MMA(1, 1, At, B1); BAR; }
  if (wr == 0) BAR;
  if (nx.valid) {
    const char* nA = (const char*)nx.A + (size_t)nx.brow * lda * 2;
    const char* nB = (const char*)nx.B + (size_t)nx.bcol * ldb * 2;
    STAGE(SB(0, 0), nB, voffB); STAGE(SA(0, 0), nA, voffA); STAGE(SB(0, 1), nB + hstepB, voffB); STAGE(SA(0, 1), nA + hstepA, voffA);
  }
  epi(acc, brow + wr * 64 + fr, bcol + wc * 32 + fq * 4);
#undef SA
#undef SB
#undef STAGE
#undef LDA
#undef LDB
#undef MMA
}
#define EPI_LOOP(ai, bj, m, n) \
  _Pragma("unroll") for (int ai = 0; ai < 2; ++ai) _Pragma("unroll") for (int bj = 0; bj < 2; ++bj) \
  _Pragma("unroll") for (int m = 0; m < 4; ++m) _Pragma("unroll") for (int n = 0; n < 2; ++n)

typedef f32x4 (&AccRef)[2][2][4][2];

DEV void tile_map(int t, int nM, int nN, int& pm, int& pn) {
  const int NX = 8, WGM = 8;
  int nwg = nM * nN;
  int q = nwg / NX, r = nwg % NX, xcd = t % NX, off = t / NX;
  int wgid = (xcd < r ? xcd * (q + 1) : r * (q + 1) + (xcd - r) * q) + off;
  int nig = WGM * nN, gid = wgid / nig, fm = gid * WGM, gsz = min(nM - fm, WGM);
  pm = fm + ((wgid % nig) % gsz);
  pn = (wgid % nig) / gsz;
}

DEV void store_bf4(u16* dst, f32x4 v) {
  uint2 w; w.x = pack2(v[0], v[1]); w.y = pack2(v[2], v[3]);
  *(uint2*)dst = w;
}

DEV void transpose_tile(const float* __restrict__ src, int ld, int k0, int c0, u16* __restrict__ dst, int lddst, int drow0) {
  float* t = (float*)smem;
  int tid = threadIdx.x, lx = tid & 63, ly = tid >> 6;
#pragma unroll
  for (int i = 0; i < 8; ++i) { int r = ly + 8 * i; t[r * 65 + lx] = src[(size_t)(k0 + r) * ld + c0 + lx]; }
  __syncthreads();
  {
    const int j = tid >> 3, ks = tid & 7;
    float v[8];
#pragma unroll
    for (int e = 0; e < 8; ++e) v[e] = t[(ks * 8 + e) * 65 + j];
    *(uint4*)&dst[(size_t)(drow0 + j) * lddst + k0 + ks * 8] = pack8(v);
  }
  __syncthreads();
}

DEV void phase_prep(const Params& p) {
  char* ws = p.ws;
  const int G = gridDim.x;
  for (int ti = blockIdx.x; ti < 4608; ti += G) {
    if (ti < 1600) {
      int kt = ti / 100, ct = ti % 100;
      int c0 = ct * 64 < 2304 ? ct * 64 : ct * 64 + 8;
      transpose_tile(p.w_in, WIN_LD, kt * 64, c0, (u16*)(ws + WS_WIN), 1024, ct * 64);
    } else if (ti < 1856) {
      int t2 = ti - 1600, kt = t2 / 16, ct = t2 % 16;
      transpose_tile(p.w_mem_kv, 1024, kt * 64, ct * 64, (u16*)(ws + WS_WMEM), 1024, ct * 64);
    } else if (ti < 2240) {
      int t2 = ti - 1856, n = t2 / 128, r = t2 % 128, kt = r / 16, ct = r % 16;
      transpose_tile(p.w_branch + (size_t)n * 512 * 1024, 1024, kt * 64, ct * 64, (u16*)(ws + WS_WBR) + (size_t)n * 1024 * 512, 512, ct * 64);
    } else if (ti < 2496) {
      int t2 = ti - 2240, kt = t2 / 16, ct = t2 % 16;
      transpose_tile(p.w_out, 1024, kt * 64, ct * 64, (u16*)(ws + WS_WOUT), 1024, ct * 64);
    } else if (ti < 3904) {
      int t2 = ti - 2496, kt = t2 / 88, ct = t2 % 88;
      int c0 = ct * 64, drow;
      if (c0 < DFF) drow = (c0 / 128) * 256 + (c0 % 128);
      else { int c1 = c0 - DFF; drow = (c1 / 128) * 256 + 128 + (c1 % 128); }
      transpose_tile(p.w_ffn_in, 2 * DFF, kt * 64, c0, (u16*)(ws + WS_WF1), 1024, drow);
    } else {
      int t2 = ti - 3904, kt = t2 / 16, ct = t2 % 16;
      transpose_tile(p.w_ffn_out, 1024, kt * 64, ct * 64, (u16*)(ws + WS_WF2), DFF, ct * 64);
    }
  }
  if (blockIdx.x == 0 && threadIdx.x < 16) ((unsigned*)(ws + WS_CTR))[threadIdx.x] = 0u;
  {
    float2* rope = (float2*)(ws + WS_ROPE);
    for (int idx = blockIdx.x * 512 + threadIdx.x; idx < 8196 * 32; idx += G * 512) {
      int pi = idx >> 5, i = idx & 31;
      int pos = pi < 8192 ? pi : 16384 + (pi - 8192);
      float ang = (float)pos * ROPE_INV[i];
      double rev = (double)ang * 0.15915494309189535;
      float fr = (float)(rev - floor(rev));
      rope[idx] = make_float2(__builtin_amdgcn_cosf(fr), __builtin_amdgcn_sinf(fr));
    }
  }
  {
    float* wba = (float*)smem;
    __syncthreads();
    for (int i = threadIdx.x; i < 1024 * 8; i += 512) wba[i] = p.w_in[(size_t)(i >> 3) * WIN_LD + 2304 + (i & 7)];
    __syncthreads();
    int wid = threadIdx.x >> 6, lane = threadIdx.x & 63;
    for (int it = blockIdx.x; it < (TT + 1024) / 8; it += G) {
      int r = it * 8 + wid;
      const float* src; const float* gain; u16* dst;
      if (r < TP) { src = p.x_prompt + (size_t)r * DM; gain = p.ln_mix_pre; dst = (u16*)(ws + WS_H) + (size_t)r * DM; }
      else if (r < TT) { src = p.x_sample + (size_t)(r - TP) * DM; gain = p.ln_mix_pre; dst = (u16*)(ws + WS_H) + (size_t)r * DM; }
      else { src = p.mem_prompt + (size_t)(r - TT) * DM; gain = p.ln_mem; dst = (u16*)(ws + WS_HMEM) + (size_t)(r - TT) * DM; }
      float4 v[4];
      float ss = 0.f;
#pragma unroll
      for (int i = 0; i < 4; ++i) {
        v[i] = ((const float4*)src)[lane + 64 * i];
        ss += v[i].x * v[i].x + v[i].y * v[i].y + v[i].z * v[i].z + v[i].w * v[i].w;
      }
      ss = wave_sum(ss);
      float rstd = rsqrtf(ss * (1.f / DM) + EPS);
      float d8[8] = {0, 0, 0, 0, 0, 0, 0, 0};
#pragma unroll
      for (int i = 0; i < 4; ++i) {
        float4 g = ((const float4*)gain)[lane + 64 * i];
        float h0 = v[i].x * rstd * g.x, h1 = v[i].y * rstd * g.y, h2 = v[i].z * rstd * g.z, h3 = v[i].w * rstd * g.w;
        uint2 w; w.x = pack2(h0, h1); w.y = pack2(h2, h3);
        ((uint2*)dst)[lane + 64 * i] = w;
        if (r < TT) {
          int k = (lane + 64 * i) * 4;
          float hh[4] = {h0, h1, h2, h3};
#pragma unroll
          for (int e = 0; e < 4; ++e) {
            float4 wa = *(const float4*)&wba[(k + e) * 8], wb = *(const float4*)&wba[(k + e) * 8 + 4];
            d8[0] += hh[e] * wa.x; d8[1] += hh[e] * wa.y; d8[2] += hh[e] * wa.z; d8[3] += hh[e] * wa.w;
            d8[4] += hh[e] * wb.x; d8[5] += hh[e] * wb.y; d8[6] += hh[e] * wb.z; d8[7] += hh[e] * wb.w;
          }
        }
      }
      if (r < TT) {
#pragma unroll
        for (int c = 0; c < 8; ++c) d8[c] = wave_sum(d8[c]);
        if (lane == 0) {
          float* ba = (float*)(ws + WS_BA) + (size_t)r * 8;
          *(float4*)ba = make_float4(d8[0], d8[1], d8[2], d8[3]);
          *(float4*)(ba + 4) = make_float4(d8[4], d8[5], d8[6], d8[7]);
        }
      }
    }
    __syncthreads();
  }
}

DEV void gemm_p1_phase(const Params& p) {
  char* ws = p.ws;
  const int G = gridDim.x;
  bool pre = false;
  for (int t = blockIdx.x; t < 1706; t += G) {
    const int tn = t + G;
    GNext nx{nullptr, nullptr, 0, 0, 0};
    if (tn < 1706) {
      if (tn < 1690) { int pm, pn; tile_map(tn, 130, 13, pm, pn); nx = GNext{(const u16*)(ws + WS_H), (const u16*)(ws + WS_WIN), pm * 256, pn * 256, 1}; }
      else { int t2 = tn - 1690; nx = GNext{(const u16*)(ws + WS_HMEM), (const u16*)(ws + WS_WMEM), (t2 >> 2) * 256, (t2 & 3) * 256, 1}; }
    }
    if (t < 1690) {
      int pm, pn; tile_map(t, 130, 13, pm, pn);
      u16* P1 = (u16*)(ws + WS_P1);
      gemm_tile((const u16*)(ws + WS_H), 1024, (const u16*)(ws + WS_WIN), 1024, 1024, pm * 256, pn * 256, pre, nx,
                [&](AccRef acc, int r0, int c0) {
                  EPI_LOOP(ai, bj, m, n) {
                    int row = r0 + ai * 128 + m * 16, col = c0 + bj * 128 + n * 16;
                    store_bf4(P1 + (size_t)row * NP1 + col, acc[ai][bj][m][n]);
                  }
                });
    } else {
      int t2 = t - 1690, pm = t2 >> 2, pn = t2 & 3;
      u16* MK = (u16*)(ws + WS_MEMKV);
      float* out = p.out;
      gemm_tile((const u16*)(ws + WS_HMEM), 1024, (const u16*)(ws + WS_WMEM), 1024, 1024, pm * 256, pn * 256, pre, nx,
                [&](AccRef acc, int r0, int c0) {
                  EPI_LOOP(ai, bj, m, n) {
                    int row = r0 + ai * 128 + m * 16, col = c0 + bj * 128 + n * 16;
                    f32x4 v = acc[ai][bj][m][n];
                    store_bf4(MK + (size_t)row * 1024 + col, v);
                    float* o = col < 512 ? out + OFF_MKP + (size_t)row * 512 + col : out + OFF_MVP + (size_t)row * 512 + (col - 512);
                    *(float4*)o = make_float4(v[0], v[1], v[2], v[3]);
                  }
                });
    }
    pre = nx.valid;
  }
}

DEV int kperm(int k) { return (k & ~31) | (((k >> 2) & 3) << 3) | (((k >> 4) & 1) << 2) | (k & 3); }
DEV float softplusf_(float x) { return x > 20.f ? x : log1pf(__expf(x)); }

DEV void gdn_pre_item(const Params& p, int item) {
  char* ws = p.ws;
  const u16* P1 = (const u16*)(ws + WS_P1);
  int n = item & 127, bh = item >> 7, h = bh & 3, b = bh >> 2;
  int tid = threadIdx.x, lane = tid & 63, wid = tid >> 6, fr = lane & 15, fq = lane >> 4;
  float* qf = (float*)smem;
  float* kf = qf + 8192;
  float* vf = kf + 8192;
  u16* kb = (u16*)(vf + 8192);
  u16* qb = kb + 64 * 136;
  float* Am = (float*)(qb + 64 * 136);
  float* s_g = Am + 64 * 68;
  float* s_beta = s_g + 64;
  float* s_gc = s_beta + 64;
  float* s_rq = s_gc + 64;
  float* s_rk = s_rq + 64;
  float* s_fw = s_rk + 64;
  u16* gs = (u16*)(ws + WS_GS) + (size_t)item * GS_ITEM;
  u16* g_w = gs, *g_qe = gs + 8192, *g_kdT = gs + 16384, *g_uT = gs + 24576, *g_qk = gs + 32768;
  const size_t tokbase = (size_t)b * SEQ + (size_t)n * 64;

  if (tid < 384) {
    int cgp = tid % 48, tg = tid / 48, part = cgp >> 4, d0 = (cgp & 15) * 8;
    int ch = part * 512 + h * 128 + d0;
    uint4 rawp[11];
#pragma unroll
    for (int r = 0; r < 11; ++r) {
      int l = n * 64 + tg * 8 - 3 + r;
      rawp[r] = make_uint4(0, 0, 0, 0);
      if (l >= 0) rawp[r] = *(const uint4*)(P1 + ((size_t)b * SEQ + l) * NP1 + C_QKVB + ch);
    }
    float* dstb = part == 0 ? qf : (part == 1 ? kf : vf);
#pragma unroll
    for (int eh = 0; eh < 2; ++eh) {
      float cw[4][4];
#pragma unroll
      for (int j = 0; j < 4; ++j) {
        float4 a = *(const float4*)(p.gdn_conv_w + j * 1536 + ch + eh * 4);
        cw[j][0] = a.x; cw[j][1] = a.y; cw[j][2] = a.z; cw[j][3] = a.w;
      }
#pragma unroll
      for (int i = 0; i < 8; ++i) {
        float o[4];
#pragma unroll
        for (int e = 0; e < 4; ++e) {
          float s = 0.f;
#pragma unroll
          for (int j = 0; j < 4; ++j) {
            unsigned w = eh == 0 ? (e < 2 ? rawp[i + j].x : rawp[i + j].y) : (e < 2 ? rawp[i + j].z : rawp[i + j].w);
            float x = (e & 1) ? bfhi(w) : bflo(w);
            s += x * cw[j][e];
          }
          o[e] = siluf_(s);
        }
        *(float4*)(dstb + (tg * 8 + i) * 128 + d0 + eh * 4) = make_float4(o[0], o[1], o[2], o[3]);
      }
    }
    if (n == 127 && tg == 7) {
#pragma unroll
      for (int i = 5; i < 8; ++i) {
        float* o = p.out + OFF_CVP + ((size_t)b * 3 + (i - 5)) * 1536 + ch;
        float x[8];
        unpack8(rawp[i + 3], x);
        *(float4*)o = make_float4(x[0], x[1], x[2], x[3]);
        *(float4*)(o + 4) = make_float4(x[4], x[5], x[6], x[7]);
      }
    }
  } else if (tid < 448) {
    int i = tid - 384;
    const float* ba = (const float*)(ws + WS_BA) + (tokbase + i) * 8;
    float braw = ba[h], araw = ba[4 + h];
    s_beta[i] = sigmoidf_(braw);
    s_g[i] = -__expf(p.gdn_a_log[h]) * softplusf_(araw + p.gdn_dt_bias[h]);
  }
  __syncthreads();
  if (tid < 128) {
    int i = tid & 63, which = tid >> 6;
    const float* src = (which ? kf : qf) + i * 128;
    float ss = 0.f;
#pragma unroll 8
    for (int j = 0; j < 128; ++j) { float x = src[(j + lane) & 127]; ss += x * x; }
    float rs = rsqrtf(ss + EPS);
    if (which) s_rk[i] = rs; else s_rq[i] = rs * 0.08838834764831845f;
  } else if (tid < 192) {
    float v = s_g[lane];
#pragma unroll
    for (int o = 1; o < 64; o <<= 1) { float t = __shfl_up(v, o); if (lane >= o) v += t; }
    s_gc[lane] = v;
  }
  __syncthreads();
  {
    const int d2 = (tid & 63) * 2, r0 = tid >> 6;
#pragma unroll
    for (int r = 0; r < 8; ++r) {
      int i = r0 * 8 + r;
      float rq = s_rq[i], rk = s_rk[i];
      float2 qv = *(const float2*)&qf[i * 128 + d2], kv = *(const float2*)&kf[i * 128 + d2];
      *(unsigned*)&qb[i * 136 + d2] = pack2(qv.x * rq, qv.y * rq);
      *(unsigned*)&kb[i * 136 + d2] = pack2(kv.x * rk, kv.y * rk);
    }
    if (tid < 64) s_fw[tid] = s_beta[tid] * s_rk[tid] * __expf(s_gc[tid]);
  }
  __syncthreads();
#pragma unroll 1
  for (int tt = 0; tt < 4; ++tt) {
    int id = wid * 4 + tt, which = id >> 4, it = (id & 15) >> 2, jt = id & 3;
    if (jt > it) {
      if (which) {
#pragma unroll
        for (int jj = 0; jj < 4; ++jj) g_qk[(it * 16 + fq * 4 + jj) * 64 + kperm(jt * 16 + fr)] = 0;
      }
      continue;
    }
    const u16* X = which ? qb : kb;
    f32x4 acc = {0.f, 0.f, 0.f, 0.f};
#pragma unroll
    for (int ks = 0; ks < 4; ++ks) {
      bf16x8 a = *(const bf16x8*)&X[(it * 16 + fr) * 136 + ks * 32 + fq * 8];
      bf16x8 bb = *(const bf16x8*)&kb[(jt * 16 + fr) * 136 + ks * 32 + fq * 8];
      acc = MFMA16(a, bb, acc);
    }
    int j = jt * 16 + fr;
    float gj = s_gc[j];
#pragma unroll
    for (int jj = 0; jj < 4; ++jj) {
      int i = it * 16 + fq * 4 + jj;
      float dec = __expf(fminf(s_gc[i] - gj, 0.f));
      if (which) g_qk[i * 64 + kperm(j)] = f2bf(j <= i ? acc[jj] * dec : 0.f);
      else Am[i * 68 + j] = (j < i) ? s_beta[i] * acc[jj] * dec : 0.f;
    }
  }
  __syncthreads();
  if (tid < 256) {
    int c = tid;
    const float* src = (c < 128) ? (vf + c) : (kf + (c - 128));
    const float* fac = (c < 128) ? s_beta : s_fw;
    int dz;
    asm volatile("v_mov_b32 %0, 0" : "=v"(dz));
    const float* AmV = Am + dz;
    fac += dz;
    float sol[64];
#pragma unroll
    for (int i = 0; i < 64; ++i) {
      float s0 = src[i * 128] * fac[i], s1 = 0.f, s2 = 0.f, s3 = 0.f;
      constexpr int NB = 12;
#pragma unroll
      for (int jb = 0; jb < (i + 3) / 4; jb += NB) {
        float4 a[NB];
#pragma unroll
        for (int j4 = jb; j4 < (i + 3) / 4 && j4 < jb + NB; ++j4) a[j4 - jb] = *(const float4*)&AmV[i * 68 + j4 * 4];
#pragma unroll
        for (int j4 = jb; j4 < (i + 3) / 4 && j4 < jb + NB; ++j4) {
          if (j4 * 4 + 0 < i) s0 -= a[j4 - jb].x * sol[j4 * 4 + 0];
          if (j4 * 4 + 1 < i) s1 -= a[j4 - jb].y * sol[j4 * 4 + 1];
          if (j4 * 4 + 2 < i) s2 -= a[j4 - jb].z * sol[j4 * 4 + 2];
          if (j4 * 4 + 3 < i) s3 -= a[j4 - jb].w * sol[j4 * 4 + 3];
        }
        __builtin_amdgcn_sched_barrier(0);
      }
      sol[i] = (s0 + s1) + (s2 + s3);
      __builtin_amdgcn_sched_barrier(0);
    }
    if (c < 128) {
#pragma unroll
      for (int i8 = 0; i8 < 8; ++i8) *(uint4*)&g_uT[c * 64 + i8 * 8] = pack8(&sol[i8 * 8]);
    } else {
#pragma unroll
      for (int i = 0; i < 64; ++i) g_w[i * 128 + kperm(c - 128)] = f2bf(sol[i]);
    }
  } else {
    int t2 = tid - 256;
    {
      const int dgrp = t2 & 15, seg = dgrp >> 2, e8 = dgrp & 3;
#pragma unroll
      for (int r = 0; r < 4; ++r) {
        const int i = (t2 >> 4) + 16 * r;
        const float f = s_rq[i] * __expf(s_gc[i]);
        float o[8];
        {
          float4 a = *(const float4*)&qf[i * 128 + dgrp * 8], c = *(const float4*)&qf[i * 128 + dgrp * 8 + 4];
          o[0] = a.x * f; o[1] = a.y * f; o[2] = a.z * f; o[3] = a.w * f; o[4] = c.x * f; o[5] = c.y * f; o[6] = c.z * f; o[7] = c.w * f;
        }
        {
          uint4 pk = pack8(o);
          int pb = i * 128 + seg * 32 + ((e8 & 1) * 2) * 8 + (e8 >> 1) * 4;
          *(uint2*)&g_qe[pb] = make_uint2(pk.x, pk.y);
          *(uint2*)&g_qe[pb + 8] = make_uint2(pk.z, pk.w);
        }
      }
    }
    {
      int d = t2 >> 1, ih = t2 & 1;
      float gl = s_gc[63];
#pragma unroll
      for (int e8 = 0; e8 < 4; ++e8) {
        float o[8];
#pragma unroll
        for (int e = 0; e < 8; ++e) {
          int i = ih * 32 + e8 * 8 + e;
          o[e] = kf[i * 128 + d] * s_rk[i] * __expf(gl - s_gc[i]);
        }
        {
          uint4 pk = pack8(o);
          int pb = d * 64 + ih * 32 + ((e8 & 1) * 2) * 8 + (e8 >> 1) * 4;
          *(uint2*)&g_kdT[pb] = make_uint2(pk.x, pk.y);
          *(uint2*)&g_kdT[pb + 8] = make_uint2(pk.z, pk.w);
        }
      }
    }
    if (t2 == 0) ((float*)(ws + WS_GAM))[item] = __expf(s_gc[63]);
  }
  __syncthreads();
}

constexpr int SC_W = 0, SC_QE = 8704, SC_KD = 17408, SC_QK = 26624, SC_O = 31232, SC_BUF = 35840;
template <int MODE>
DEV void gdn_scan(const Params& p, int sid) {
  char* ws = p.ws;
  const u16* P1 = (const u16*)(ws + WS_P1);
  u16* BR = MODE == 0 ? (u16*)(p.out) : (u16*)(ws + WS_STASH);
  const int bh = sid >> 1, sl = sid & 1, h = bh & 3, b = bh >> 2;
  const int tid = threadIdx.x, lane = tid & 63, wid = __builtin_amdgcn_readfirstlane(tid >> 6), fr = lane & 15, fq = lane >> 4;
  u16* bufs = (u16*)smem;
  const u16* gsb = (const u16*)(ws + WS_GS) + (size_t)bh * 128 * GS_ITEM;
  const float* gam = (const float*)(ws + WS_GAM) + bh * 128;
  float* ssq = MODE == 0 ? (float*)(ws + WS_SSQ) : (float*)(ws + WS_STASH + (size_t)110 * 1024 * 1024);
  __syncthreads();
  if (wid >= 4) {
    const int t = tid - 256;
    const unsigned so0 = ((((0*256+t)>>4)*128) + (((0*256+t)&15)*8)), do0 = (SC_W + (((0*256+t)>>4)*136) + (((0*256+t)&15)*8));
    const unsigned so1 = ((((1*256+t)>>4)*128) + (((1*256+t)&15)*8)), do1 = (SC_W + (((1*256+t)>>4)*136) + (((1*256+t)&15)*8));
    const unsigned so2 = ((((2*256+t)>>4)*128) + (((2*256+t)&15)*8)), do2 = (SC_W + (((2*256+t)>>4)*136) + (((2*256+t)&15)*8));
    const unsigned so3 = ((((3*256+t)>>4)*128) + (((3*256+t)&15)*8)), do3 = (SC_W + (((3*256+t)>>4)*136) + (((3*256+t)&15)*8));
    const unsigned so4 = (8192 + (((0*256+t)>>4)*128) + (((0*256+t)&15)*8)), do4 = (SC_QE + (((0*256+t)>>4)*136) + (((0*256+t)&15)*8));
    const unsigned so5 = (8192 + (((1*256+t)>>4)*128) + (((1*256+t)&15)*8)), do5 = (SC_QE + (((1*256+t)>>4)*136) + (((1*256+t)&15)*8));
    const unsigned so6 = (8192 + (((2*256+t)>>4)*128) + (((2*256+t)&15)*8)), do6 = (SC_QE + (((2*256+t)>>4)*136) + (((2*256+t)&15)*8));
    const unsigned so7 = (8192 + (((3*256+t)>>4)*128) + (((3*256+t)&15)*8)), do7 = (SC_QE + (((3*256+t)>>4)*136) + (((3*256+t)&15)*8));
    const unsigned so8 = (16384 + (((0*256+t)>>3)*64) + (((0*256+t)&7)*8)), do8 = (SC_KD + (((0*256+t)>>3)*72) + (((0*256+t)&7)*8));
    const unsigned so9 = (16384 + (((1*256+t)>>3)*64) + (((1*256+t)&7)*8)), do9 = (SC_KD + (((1*256+t)>>3)*72) + (((1*256+t)&7)*8));
    const unsigned so10 = (16384 + (((2*256+t)>>3)*64) + (((2*256+t)&7)*8)), do10 = (SC_KD + (((2*256+t)>>3)*72) + (((2*256+t)&7)*8));
    const unsigned so11 = (16384 + (((3*256+t)>>3)*64) + (((3*256+t)&7)*8)), do11 = (SC_KD + (((3*256+t)>>3)*72) + (((3*256+t)&7)*8));
    const unsigned so12 = (32768 + (((0*256+t)>>3)*64) + (((0*256+t)&7)*8)), do12 = (SC_QK + (((0*256+t)>>3)*72) + (((0*256+t)&7)*8));
    const unsigned so13 = (32768 + (((1*256+t)>>3)*64) + (((1*256+t)&7)*8)), do13 = (SC_QK + (((1*256+t)>>3)*72) + (((1*256+t)&7)*8));
    const int otok = t >> 2, oseg = t & 3;
    const u16* zbase = P1 + ((size_t)b * SEQ + otok) * NP1 + C_ZB + h * 128 + sl * 64 + oseg * 16;
    u16* obase = BR + ((size_t)b * SEQ + otok) * 1536 + 512 + h * 128 + sl * 64 + oseg * 16;
    float* qbase = ssq + (((size_t)b * SEQ + otok) * 4 + h) * 2 + sl;
    float nwv[16];
#pragma unroll
    for (int e = 0; e < 16; ++e) nwv[e] = p.gdn_norm_w[sl * 64 + oseg * 16 + e];
    uint4 sa0, sa1, sa2, sa3, sa4, sa5, sa6, sa7, sa8, sa9, sa10, sa11, sa12, sa13, sa14, sa15;
    uint4 sb_0, sb_1, sb_2, sb_3, sb_4, sb_5, sb_6, sb_7, sb_8, sb_9, sb_10, sb_11, sb_12, sb_13, sb_14, sb_15;
#define GLOADS_A(n_, nz_) do { const u16* gs_ = gsb + (size_t)(n_)*GS_ITEM; const u16* zb_ = zbase + (size_t)((nz_)*64) * NP1; sa0 = *(const uint4*)(gs_ + so0); sa1 = *(const uint4*)(gs_ + so1); sa2 = *(const uint4*)(gs_ + so2); sa3 = *(const uint4*)(gs_ + so3); sa4 = *(const uint4*)(gs_ + so4); sa5 = *(const uint4*)(gs_ + so5); sa6 = *(const uint4*)(gs_ + so6); sa7 = *(const uint4*)(gs_ + so7); sa8 = *(const uint4*)(gs_ + so8); sa9 = *(const uint4*)(gs_ + so9); sa10 = *(const uint4*)(gs_ + so10); sa11 = *(const uint4*)(gs_ + so11); sa12 = *(const uint4*)(gs_ + so12); sa13 = *(const uint4*)(gs_ + so13); sa14 = *(const uint4*)(zb_); sa15 = *(const uint4*)(zb_ + 8); } while (0)
#define GLOADS_B(n_, nz_) do { const u16* gs_ = gsb + (size_t)(n_)*GS_ITEM; const u16* zb_ = zbase + (size_t)((nz_)*64) * NP1; sb_0 = *(const uint4*)(gs_ + so0); sb_1 = *(const uint4*)(gs_ + so1); sb_2 = *(const uint4*)(gs_ + so2); sb_3 = *(const uint4*)(gs_ + so3); sb_4 = *(const uint4*)(gs_ + so4); sb_5 = *(const uint4*)(gs_ + so5); sb_6 = *(const uint4*)(gs_ + so6); sb_7 = *(const uint4*)(gs_ + so7); sb_8 = *(const uint4*)(gs_ + so8); sb_9 = *(const uint4*)(gs_ + so9); sb_10 = *(const uint4*)(gs_ + so10); sb_11 = *(const uint4*)(gs_ + so11); sb_12 = *(const uint4*)(gs_ + so12); sb_13 = *(const uint4*)(gs_ + so13); sb_14 = *(const uint4*)(zb_); sb_15 = *(const uint4*)(zb_ + 8); } while (0)
#define SSTORES_A(buf_) do { u16* bb_ = (buf_); *(uint4*)(bb_ + do0) = sa0; *(uint4*)(bb_ + do1) = sa1; *(uint4*)(bb_ + do2) = sa2; *(uint4*)(bb_ + do3) = sa3; *(uint4*)(bb_ + do4) = sa4; *(uint4*)(bb_ + do5) = sa5; *(uint4*)(bb_ + do6) = sa6; *(uint4*)(bb_ + do7) = sa7; *(uint4*)(bb_ + do8) = sa8; *(uint4*)(bb_ + do9) = sa9; *(uint4*)(bb_ + do10) = sa10; *(uint4*)(bb_ + do11) = sa11; *(uint4*)(bb_ + do12) = sa12; *(uint4*)(bb_ + do13) = sa13; } while (0)
#define SSTORES_B(buf_) do { u16* bb_ = (buf_); *(uint4*)(bb_ + do0) = sb_0; *(uint4*)(bb_ + do1) = sb_1; *(uint4*)(bb_ + do2) = sb_2; *(uint4*)(bb_ + do3) = sb_3; *(uint4*)(bb_ + do4) = sb_4; *(uint4*)(bb_ + do5) = sb_5; *(uint4*)(bb_ + do6) = sb_6; *(uint4*)(bb_ + do7) = sb_7; *(uint4*)(bb_ + do8) = sb_8; *(uint4*)(bb_ + do9) = sb_9; *(uint4*)(bb_ + do10) = sb_10; *(uint4*)(bb_ + do11) = sb_11; *(uint4*)(bb_ + do12) = sb_12; *(uint4*)(bb_ + do13) = sb_13; } while (0)
#define OUTPROC(m_, buf_, z0_, z1_)                                                                         \
  do {                                                                                                     \
    const u16* op_ = (buf_) + SC_O + otok * 72 + oseg * 16;                                                \
    float ov_[16], zv_[16], rv_[16];                                                                       \
    unpack8(*(const uint4*)op_, ov_);                                                                      \
    unpack8(*(const uint4*)(op_ + 8), ov_ + 8);                                                            \
    unpack8(z0_, zv_);                                                                                     \
    unpack8(z1_, zv_ + 8);                                                                                 \
    float q_ = 0.f;                                                                                        \
    _Pragma("unroll") for (int e = 0; e < 16; ++e) { q_ += ov_[e] * ov_[e]; rv_[e] = ov_[e] * nwv[e] * siluf_(zv_[e]); } \
    q_ += __builtin_bit_cast(float, __builtin_amdgcn_update_dpp(0, __builtin_bit_cast(int, q_), 0xB1, 0xf, 0xf, true)); \
    q_ += __builtin_bit_cast(float, __builtin_amdgcn_update_dpp(0, __builtin_bit_cast(int, q_), 0x4E, 0xf, 0xf, true)); \
    u16* od_ = obase + (size_t)((m_)*64) * 1536;                                                           \
    *(uint4*)od_ = pack8(rv_);                                                                             \
    *(uint4*)(od_ + 8) = pack8(rv_ + 8);                                                                   \
    if (oseg == 0) qbase[(size_t)((m_)*64) * 8] = q_;                                                      \
  } while (0)
    GLOADS_A(0, 0);
    SSTORES_A(bufs);
    __builtin_amdgcn_sched_barrier(0);
    GLOADS_B(1, 0);
    __builtin_amdgcn_sched_barrier(0);
    GLOADS_A(2, 0);
    __builtin_amdgcn_sched_barrier(0);
    __syncthreads();
#pragma unroll 1
    for (int n = 0; n < 128; n += 2) {
      if (n > 0) OUTPROC(n - 1, bufs + SC_BUF, sb_14, sb_15);
      SSTORES_B(bufs + SC_BUF);
      GLOADS_B(min(n + 3, 127), n + 1);
      __syncthreads();
      OUTPROC(n, bufs, sa14, sa15);
      SSTORES_A(bufs);
      GLOADS_A(min(n + 4, 127), min(n + 2, 127));
      __syncthreads();
    }
    OUTPROC(127, bufs + SC_BUF, sb_14, sb_15);
#undef GLOADS_A
#undef GLOADS_B
#undef SSTORES_A
#undef SSTORES_B
#undef OUTPROC
  } else {
    const int dvl = wid * 16 + fr;
    const int dv = sl * 64 + dvl;
    f32x4 S[8];
#pragma unroll
    for (int t = 0; t < 8; ++t) S[t] = f32x4{0.f, 0.f, 0.f, 0.f};
    bf16x4 ua[4], ub[4];
    float ga, gb;
#define PFLOAD(ud, gd, n_)                                                                                 \
  do {                                                                                                     \
    const u16* guT = gsb + (size_t)(n_)*GS_ITEM + 24576 + dv * 64 + fq * 4;                                \
    _Pragma("unroll") for (int mt = 0; mt < 4; ++mt) ud[mt] = *(const bf16x4*)(guT + mt * 16);             \
    gd = gam[n_];                                                                                          \
  } while (0)
#define SCAN_STEP(n_, buf_, uu, gamma)                                                                     \
  do {                                                                                                     \
    const u16* buf = (buf_);                                                                               \
    bf16x8 sb[4];                                                                                          \
    _Pragma("unroll") for (int s = 0; s < 4; ++s) sb[s] = pack_acc2(S[2 * s], S[2 * s + 1]);              \
    f32x4 vn[4], oo[4];                                                                                    \
    {                                                                                                      \
      bf16x8 fw[16];                                                                                       \
      _Pragma("unroll") for (int i = 0; i < 16; ++i) fw[i] = *(const bf16x8*)(buf + SC_W + ((i >> 2) * 16 + fr) * 136 + (i & 3) * 32 + fq * 8);  \
      __builtin_amdgcn_sched_barrier(0);                                                                   \
      _Pragma("unroll") for (int mt = 0; mt < 4; ++mt) {                                                   \
        f32x4 a = {0.f, 0.f, 0.f, 0.f};                                                                    \
        _Pragma("unroll") for (int s = 0; s < 4; ++s) a = MFMA16(fw[mt * 4 + s], sb[s], a);                \
        vn[mt] = a;                                                                                        \
      }                                                                                                    \
    }                                                                                                      \
    __builtin_amdgcn_sched_barrier(0);                                                                     \
    bf16x8 vb[2];                                                                                          \
    {                                                                                                      \
      bf16x8 fe[16], fk[8];                                                                                \
      _Pragma("unroll") for (int i = 0; i < 16; ++i) fe[i] = *(const bf16x8*)(buf + SC_QE + ((i >> 2) * 16 + fr) * 136 + (i & 3) * 32 + fq * 8); \
      _Pragma("unroll") for (int i = 0; i < 8; ++i) fk[i] = *(const bf16x8*)(buf + SC_QK + ((i >> 1) * 16 + fr) * 72 + (i & 1) * 32 + fq * 8);   \
      _Pragma("unroll") for (int mt = 0; mt < 4; ++mt)                                                     \
        _Pragma("unroll") for (int jj = 0; jj < 4; ++jj) vn[mt][jj] = bf2f((u16)uu[mt][jj]) - vn[mt][jj];  \
      vb[0] = pack_acc2(vn[0], vn[1]);                                                                     \
      vb[1] = pack_acc2(vn[2], vn[3]);                                                                     \
      __builtin_amdgcn_sched_barrier(0);                                                                   \
      _Pragma("unroll") for (int mt = 0; mt < 4; ++mt) {                                                   \
        f32x4 a = {0.f, 0.f, 0.f, 0.f};                                                                    \
        _Pragma("unroll") for (int s = 0; s < 4; ++s) a = MFMA16(fe[mt * 4 + s], sb[s], a);                \
        _Pragma("unroll") for (int s = 0; s < 2; ++s) a = MFMA16(fk[mt * 2 + s], vb[s], a);                \
        oo[mt] = a;                                                                                        \
      }                                                                                                    \
    }                                                                                                      \
    __builtin_amdgcn_sched_barrier(0);                                                                     \
    {                                                                                                      \
      bf16x8 fd[16];                                                                                       \
      _Pragma("unroll") for (int i = 0; i < 16; ++i) fd[i] = *(const bf16x8*)(buf + SC_KD + ((i >> 1) * 16 + fr) * 72 + (i & 1) * 32 + fq * 8);  \
      __builtin_amdgcn_sched_barrier(0);                                                                   \
      _Pragma("unroll") for (int t = 0; t < 8; ++t) {                                                      \
        f32x4 a = S[t] * gamma;                                                                            \
        _Pragma("unroll") for (int s = 0; s < 2; ++s) a = MFMA16(fd[t * 2 + s], vb[s], a);                 \
        S[t] = a;                                                                                          \
      }                                                                                                    \
    }                                                                                                      \
    {                                                                                                      \
      u16* ow_ = (u16*)buf + SC_O + (fq * 4) * 72 + dvl;                                                   \
      _Pragma("unroll") for (int mt = 0; mt < 4; ++mt)                                                     \
        _Pragma("unroll") for (int jj = 0; jj < 4; ++jj) ow_[(mt * 16 + jj) * 72] = f2bf(oo[mt][jj]);      \
    }                                                                                                      \
  } while (0)
    PFLOAD(ua, ga, 0);
    PFLOAD(ub, gb, 1);
    __syncthreads();
#pragma unroll 1
    for (int n = 0; n < 128; n += 2) {
      if (MODE != 3) SCAN_STEP(n, bufs, ua, ga);
      PFLOAD(ua, ga, min(n + 2, 127));
      __syncthreads();
      if (MODE != 3) SCAN_STEP(n + 1, bufs + SC_BUF, ub, gb);
      PFLOAD(ub, gb, min(n + 3, 127));
      __syncthreads();
    }
#undef PFLOAD
#undef SCAN_STEP
    float* rec = MODE == 0 ? p.out + OFF_RECP + (size_t)bh * 128 * 128 : (float*)(ws + WS_STASH + (size_t)120 * 1024 * 1024) + (size_t)bh * 128 * 128;
#pragma unroll
    for (int t = 0; t < 8; ++t)
#pragma unroll
      for (int jj = 0; jj < 4; ++jj) rec[(t * 16 + fq * 4 + jj) * 128 + dv] = S[t][jj] + (MODE == 3 ? ua[0][0] + ub[0][0] + ga + gb : 0.f);
  }
}

DEV void gdn_finalize(const Params& p) {
  char* ws = p.ws;
  u16* BR = (u16*)(p.out);
  const float* ssq = (const float*)(ws + WS_SSQ);
  int wid = threadIdx.x >> 6, lane = threadIdx.x & 63;
  for (int it = blockIdx.x; it < TP / 8; it += gridDim.x) {
    size_t tok = (size_t)it * 8 + wid;
    int hh = lane >> 4;
    const float2 sp = *(const float2*)(ssq + (tok * 4 + hh) * 2);
    float tot = sp.x + sp.y;
    float rstd = rsqrtf(tot * (1.f / 128.f) + EPS);
    u16* d = BR + tok * 1536 + 512 + lane * 8;
    float v[8];
    unpack8(*(const uint4*)d, v);
#pragma unroll
    for (int e = 0; e < 8; ++e) v[e] *= rstd;
    *(uint4*)d = pack8(v);
  }
}

template <bool SWA>
DEV void attn_item(const Params& p, int item) {
  constexpr int HD = SWA ? 64 : 128;
  constexpr int KST = HD + 8;
  constexpr int VST = 264;
  constexpr int NKS = HD / 32;
  constexpr int NDT = HD / 16;
  constexpr int NKT = SWA ? 9 : 16;
  constexpr int NSL = (NKT + 1) / 2;
  char* ws = p.ws;
  const u16* P1 = (const u16*)(ws + WS_P1);
  u16* BR = (u16*)(p.out);
  const float2* rope = (const float2*)(ws + WS_ROPE);
  u16* Ks = (u16*)smem;
  u16* Vt = Ks + 256 * KST;
  int tid = threadIdx.x, lane = tid & 63, wid = tid >> 6, fr = lane & 15, fq = lane >> 4;
  int b, nb = 0, kvh = 0, h = 0, qblk = 0;
  if (SWA) { kvh = item & 1; nb = (item >> 1) & 63; b = item >> 7; }
  else { qblk = item & 31; h = (item >> 5) & 3; b = item >> 7; }

  __syncthreads();
  if (SWA) {
#pragma unroll
    for (int i = 0; i < 2; ++i) {
      int task = tid + 512 * i, s = task >> 2, dg = task & 3;
      int pos = (nb - 1) * 128 + s;
      float x1[8], x2[8];
      if (pos >= 0) {
        const u16* src = P1 + ((size_t)b * SEQ + pos) * NP1 + C_KA + kvh * 64 + dg * 8;
        unpack8(*(const uint4*)src, x1);
        unpack8(*(const uint4*)(src + 32), x2);
        const float4* rp = (const float4*)(rope + (size_t)pos * 32 + dg * 8);
        float o1[8], o2[8];
#pragma unroll
        for (int e2 = 0; e2 < 4; ++e2) {
          float4 cs = rp[e2];
          o1[2 * e2] = x1[2 * e2] * cs.x - x2[2 * e2] * cs.y;
          o2[2 * e2] = x2[2 * e2] * cs.x + x1[2 * e2] * cs.y;
          o1[2 * e2 + 1] = x1[2 * e2 + 1] * cs.z - x2[2 * e2 + 1] * cs.w;
          o2[2 * e2 + 1] = x2[2 * e2 + 1] * cs.z + x1[2 * e2 + 1] * cs.w;
        }
        *(uint4*)&Ks[s * KST + dg * 8] = pack8(o1);
        *(uint4*)&Ks[s * KST + 32 + dg * 8] = pack8(o2);
        if (nb == 63 && s >= 128) {
          float* o = p.out + OFF_WKP + (((size_t)b * 128 + (s - 128)) * 2 + kvh) * 64 + dg * 8;
          *(float4*)o = make_float4(o1[0], o1[1], o1[2], o1[3]);
          *(float4*)(o + 4) = make_float4(o1[4], o1[5], o1[6], o1[7]);
          *(float4*)(o + 32) = make_float4(o2[0], o2[1], o2[2], o2[3]);
          *(float4*)(o + 36) = make_float4(o2[4], o2[5], o2[6], o2[7]);
        }
      } else {
        uint4 z = make_uint4(0, 0, 0, 0);
        *(uint4*)&Ks[s * KST + dg * 8] = z;
        *(uint4*)&Ks[s * KST + 32 + dg * 8] = z;
      }
    }
#pragma unroll
    for (int i = 0; i < 4; ++i) {
      int task = tid + 512 * i, s = task & 255, dg = task >> 8;
      int pos = (nb - 1) * 128 + s;
      float x[8];
      if (pos >= 0) {
        unpack8(*(const uint4*)(P1 + ((size_t)b * SEQ + pos) * NP1 + C_VA + kvh * 64 + dg * 8), x);
        if (nb == 63 && s >= 128) {
          float* o = p.out + OFF_WVP + (((size_t)b * 128 + (s - 128)) * 2 + kvh) * 64 + dg * 8;
          *(float4*)o = make_float4(x[0], x[1], x[2], x[3]);
          *(float4*)(o + 4) = make_float4(x[4], x[5], x[6], x[7]);
        }
      } else {
#pragma unroll
        for (int e = 0; e < 8; ++e) x[e] = 0.f;
      }
#pragma unroll
      for (int e = 0; e < 8; ++e) Vt[(dg * 8 + e) * VST + s] = f2bf(x[e]);
    }
  } else {
    const u16* MK = (const u16*)(ws + WS_MEMKV);
#pragma unroll
    for (int i = 0; i < 8; ++i) {
      int task = tid + 512 * i, s = task >> 4, dg = task & 15;
      *(uint4*)&Ks[s * KST + dg * 8] = *(const uint4*)(MK + ((size_t)b * 256 + s) * 1024 + h * 128 + dg * 8);
    }
#pragma unroll
    for (int i = 0; i < 8; ++i) {
      int task = tid + 512 * i, s = task & 255, dg = task >> 8;
      uint4 v = *(const uint4*)(MK + ((size_t)b * 256 + s) * 1024 + 512 + h * 128 + dg * 8);
      const u16* ve = (const u16*)&v;
#pragma unroll
      for (int e = 0; e < 8; ++e) Vt[(dg * 8 + e) * VST + s] = ve[e];
    }
  }
  __syncthreads();

  const float LOG2E = 1.4426950408889634f;
  const float sl = (SWA ? 0.125f : 0.08838834764831845f) * LOG2E;
#pragma unroll 1
  for (int qi = 0; qi < (SWA ? 4 : 2); ++qi) {
    int qrow, kt0, head = 0;
    size_t tok;
    if (SWA) {
      int qt = (wid & 1) * 4 + qi;
      head = kvh * 4 + (wid >> 1);
      qrow = qt * 16 + fr;
      tok = (size_t)b * SEQ + nb * 128 + qrow;
      kt0 = qt;
    } else {
      qrow = wid * 32 + qi * 16 + fr;
      tok = (size_t)b * SEQ + qblk * 256 + qrow;
      kt0 = 0;
    }
    bf16x8 qf[NKS];
    if (SWA) {
      const u16* src = P1 + tok * NP1 + C_QA + head * 64 + fq * 8;
      float x1[8], x2[8], o1[8], o2[8];
      unpack8(*(const uint4*)src, x1);
      unpack8(*(const uint4*)(src + 32), x2);
      const float4* rp = (const float4*)(rope + (size_t)(nb * 128 + qrow) * 32 + fq * 8);
#pragma unroll
      for (int e2 = 0; e2 < 4; ++e2) {
        float4 cs = rp[e2];
        o1[2 * e2] = x1[2 * e2] * cs.x - x2[2 * e2] * cs.y;
        o2[2 * e2] = x2[2 * e2] * cs.x + x1[2 * e2] * cs.y;
        o1[2 * e2 + 1] = x1[2 * e2 + 1] * cs.z - x2[2 * e2 + 1] * cs.w;
        o2[2 * e2 + 1] = x2[2 * e2 + 1] * cs.z + x1[2 * e2 + 1] * cs.w;
      }
      union { uint4 u; bf16x8 v; } c1, c2;
      c1.u = pack8(o1); c2.u = pack8(o2);
      qf[0] = c1.v; qf[NKS - 1] = c2.v;
    } else {
      const u16* src = P1 + tok * NP1 + C_QC + h * 128 + fq * 8;
#pragma unroll
      for (int ks = 0; ks < NKS; ++ks) qf[ks] = *(const bf16x8*)(src + ks * 32);
    }
    f32x4 st[NKT];
#pragma unroll
    for (int j = 0; j < NKT; ++j) {
      f32x4 a = {0.f, 0.f, 0.f, 0.f};
#pragma unroll
      for (int ks = 0; ks < NKS; ++ks) {
        bf16x8 kfr = *(const bf16x8*)&Ks[((kt0 + j) * 16 + fr) * KST + ks * 32 + fq * 8];
        a = MFMA16(kfr, qf[ks], a);
      }
      st[j] = a;
      if ((j & 1) == 1) __builtin_amdgcn_sched_barrier(0);
    }
    float m2 = -INFINITY;
#pragma unroll
    for (int j = 0; j < NKT; ++j) {
#pragma unroll
      for (int jj = 0; jj < 4; ++jj) {
        float v = st[j][jj] * sl;
        if (SWA) {
          int sidx = (kt0 + j) * 16 + fq * 4 + jj;
          bool ok = (sidx > qrow) && (sidx <= qrow + 128) && (nb > 0 || sidx >= 128);
          v = ok ? v : -INFINITY;
        }
        st[j][jj] = v;
        m2 = fmaxf(m2, v);
      }
    }
    m2 = fmaxf(m2, __shfl_xor(m2, 16));
    m2 = fmaxf(m2, __shfl_xor(m2, 32));
    float sink2 = 0.f;
    if (SWA) { sink2 = p.attn_sink[head] * LOG2E; m2 = fmaxf(m2, sink2); }
    float l = 0.f;
#pragma unroll
    for (int j = 0; j < NKT; ++j) {
#pragma unroll
      for (int jj = 0; jj < 4; ++jj) {
        float pv = __builtin_amdgcn_exp2f(st[j][jj] - m2);
        st[j][jj] = pv;
        l += pv;
      }
    }
    l += __shfl_xor(l, 16);
    l += __shfl_xor(l, 32);
    if (SWA) l += __builtin_amdgcn_exp2f(sink2 - m2);
    float inv = 1.f / l;
    f32x4 ot[NDT];
#pragma unroll
    for (int dt = 0; dt < NDT; ++dt) ot[dt] = f32x4{0.f, 0.f, 0.f, 0.f};
#pragma unroll
    for (int s = 0; s < NSL; ++s) {
      bf16x8 pb;
      int t0 = kt0 + 2 * s, t1;
      if (2 * s + 1 < NKT) { pb = pack_acc2(st[2 * s], st[2 * s + 1]); t1 = t0 + 1; }
      else { f32x4 z = {0.f, 0.f, 0.f, 0.f}; pb = pack_acc2(st[2 * s], z); t1 = t0; }
#pragma unroll
      for (int dt = 0; dt < NDT; ++dt) {
        const u16* vp = Vt + (dt * 16 + fr) * VST + fq * 4;
        ot[dt] = MFMA16(mk8(*(const bf16x4*)(vp + t0 * 16), *(const bf16x4*)(vp + t1 * 16)), pb, ot[dt]);
      }
      __builtin_amdgcn_sched_barrier(0);
    }
    u16* dst = BR + tok * 1536 + (SWA ? head * 64 : 1024 + h * 128) + fq * 4;
#pragma unroll
    for (int dt = 0; dt < NDT; ++dt) store_bf4(dst + dt * 16, ot[dt] * inv);
  }
  __syncthreads();
}

DEV void swa_decode_item(const Params& p, int b) {
  char* ws = p.ws;
  const u16* P1 = (const u16*)(ws + WS_P1);
  u16* BR = (u16*)(p.out);
  const float2* rope = (const float2*)(ws + WS_ROPE);
  float* Kw = (float*)smem;
  float* Vw = Kw + 132 * 128;
  float* Qs = Vw + 132 * 128;
  float* Ps = Qs + 32 * 64;
  int tid = threadIdx.x;
  __syncthreads();
  for (int i = tid; i < 128 * 32; i += 512) {
    ((float4*)Kw)[i] = ((const float4*)(p.state_win_k + (size_t)b * 16384))[i];
    ((float4*)Vw)[i] = ((const float4*)(p.state_win_v + (size_t)b * 16384))[i];
  }
  if (tid < 256) {
    int t = tid >> 6, c = tid & 63, kvh = c >> 5, d = c & 31;
    size_t tok = (size_t)TP + b * 4 + t;
    const u16* src = P1 + tok * NP1;
    float2 cs = rope[(size_t)(8192 + t) * 32 + d];
    float x1 = bf2f(src[C_KA + kvh * 64 + d]), x2 = bf2f(src[C_KA + kvh * 64 + 32 + d]);
    Kw[(128 + t) * 128 + kvh * 64 + d] = x1 * cs.x - x2 * cs.y;
    Kw[(128 + t) * 128 + kvh * 64 + 32 + d] = x2 * cs.x + x1 * cs.y;
    Vw[(128 + t) * 128 + c] = bf2f(src[C_VA + c]);
    Vw[(128 + t) * 128 + 64 + c] = bf2f(src[C_VA + 64 + c]);
  }
  for (int i = tid; i < 4 * 8 * 32; i += 512) {
    int t = i >> 8, hh = (i >> 5) & 7, d = i & 31;
    size_t tok = (size_t)TP + b * 4 + t;
    const u16* src = P1 + tok * NP1 + C_QA + hh * 64;
    float2 cs = rope[(size_t)(8192 + t) * 32 + d];
    float x1 = bf2f(src[d]), x2 = bf2f(src[32 + d]);
    Qs[(t * 8 + hh) * 64 + d] = x1 * cs.x - x2 * cs.y;
    Qs[(t * 8 + hh) * 64 + 32 + d] = x2 * cs.x + x1 * cs.y;
  }
  __syncthreads();
  for (int i = tid; i < 128 * 32; i += 512) {
    ((float4*)(p.out + OFF_WKS + (size_t)b * 16384))[i] = ((const float4*)(Kw + 4 * 128))[i];
    ((float4*)(p.out + OFF_WVS + (size_t)b * 16384))[i] = ((const float4*)(Vw + 4 * 128))[i];
  }
  int pr = tid >> 4, sub = tid & 15, t = pr >> 3, hh = pr & 7, kvh = hh >> 2;
  const float* q = Qs + pr * 64;
  float lg[9];
  float m = -INFINITY;
#pragma unroll
  for (int r = 0; r < 9; ++r) {
    int s = sub + 16 * r;
    float v = -INFINITY;
    if (s < 132) {
      bool ok = s < 128 ? (s > t) : ((s - 128) <= t);
      if (ok) {
        const float* kp = Kw + s * 128 + kvh * 64;
        float a = 0.f;
#pragma unroll 16
        for (int d = 0; d < 64; ++d) { int dd = (d + sub * 4) & 63; a += q[dd] * kp[dd]; }
        v = a * 0.125f;
      }
    }
    lg[r] = v;
    m = fmaxf(m, v);
  }
#pragma unroll
  for (int o = 1; o < 16; o <<= 1) m = fmaxf(m, __shfl_xor(m, o));
  float sink = p.attn_sink[hh];
  m = fmaxf(m, sink);
  float l = 0.f;
#pragma unroll
  for (int r = 0; r < 9; ++r) {
    int s = sub + 16 * r;
    float pv = __expf(lg[r] - m);
    if (s < 132) Ps[pr * 132 + s] = pv;
    l += pv;
  }
#pragma unroll
  for (int o = 1; o < 16; o <<= 1) l += __shfl_xor(l, o);
  l += __expf(sink - m);
  float inv = 1.f / l;
  __syncthreads();
  float o4[4] = {0, 0, 0, 0};
  for (int s = 0; s < 132; ++s) {
    float pv = Ps[pr * 132 + s];
    float4 v = *(const float4*)(Vw + s * 128 + kvh * 64 + sub * 4);
    o4[0] += pv * v.x; o4[1] += pv * v.y; o4[2] += pv * v.z; o4[3] += pv * v.w;
  }
  size_t tok = (size_t)TP + b * 4 + t;
  uint2 w; w.x = pack2(o4[0] * inv, o4[1] * inv); w.y = pack2(o4[2] * inv, o4[3] * inv);
  *(uint2*)(BR + tok * 1536 + hh * 64 + sub * 4) = w;
  __syncthreads();
}

DEV void mem_decode_item(const Params& p, int item) {
  char* ws = p.ws;
  const u16* P1 = (const u16*)(ws + WS_P1);
  u16* BR = (u16*)(p.out);
  int h = item & 3, b = item >> 2;
  float* qs = (float*)smem;
  float* lgs = qs + 512;
  float* red = lgs + 1024;
  float* linv = red + 2048;
  int tid = threadIdx.x, lane = tid & 63, wid = tid >> 6;
  __syncthreads();
  {
    int t = tid >> 7, d = tid & 127;
    qs[tid] = bf2f(P1[((size_t)TP + b * 4 + t) * NP1 + C_QC + h * 128 + d]);
  }
  __syncthreads();
  {
    int key = tid >> 1, hf = tid & 1;
    const float4* kp = (const float4*)(p.cache_mem_k + (((size_t)b * 256 + key) * 4 + h) * 128 + hf * 64);
    float a[4] = {0, 0, 0, 0};
#pragma unroll
    for (int i = 0; i < 16; ++i) {
      float4 kv = kp[i];
#pragma unroll
      for (int t = 0; t < 4; ++t) {
        float4 qv = *(const float4*)(qs + t * 128 + hf * 64 + i * 4);
        a[t] += kv.x * qv.x + kv.y * qv.y + kv.z * qv.z + kv.w * qv.w;
      }
    }
#pragma unroll
    for (int t = 0; t < 4; ++t) a[t] += __shfl_xor(a[t], 1);
    if (hf == 0) {
#pragma unroll
      for (int t = 0; t < 4; ++t) lgs[t * 256 + key] = a[t] * 0.08838834764831845f;
    }
  }
  __syncthreads();
  if (wid < 4) {
    float v[4], m = -INFINITY;
#pragma unroll
    for (int i = 0; i < 4; ++i) { v[i] = lgs[wid * 256 + lane + 64 * i]; m = fmaxf(m, v[i]); }
#pragma unroll
    for (int o = 32; o > 0; o >>= 1) m = fmaxf(m, __shfl_xor(m, o));
    float l = 0.f;
#pragma unroll
    for (int i = 0; i < 4; ++i) { v[i] = __expf(v[i] - m); l += v[i]; lgs[wid * 256 + lane + 64 * i] = v[i]; }
    l = wave_sum(l);
    if (lane == 0) linv[wid] = 1.f / l;
  }
  __syncthreads();
  {
    int d = tid & 127, kq = tid >> 7;
    float a[4] = {0, 0, 0, 0};
    const float* vp = p.cache_mem_v + (((size_t)b * 256 + kq * 64) * 4 + h) * 128 + d;
#pragma unroll 8
    for (int s = 0; s < 64; ++s) {
      float v = vp[(size_t)s * 512];
#pragma unroll
      for (int t = 0; t < 4; ++t) a[t] += lgs[t * 256 + kq * 64 + s] * v;
    }
#pragma unroll
    for (int t = 0; t < 4; ++t) red[(kq * 4 + t) * 128 + d] = a[t];
  }
  __syncthreads();
  {
    int t = tid >> 7, d = tid & 127;
    float o = (red[(0 * 4 + t) * 128 + d] + red[(1 * 4 + t) * 128 + d] + red[(2 * 4 + t) * 128 + d] + red[(3 * 4 + t) * 128 + d]) * linv[t];
    BR[((size_t)TP + b * 4 + t) * 1536 + 1024 + h * 128 + d] = f2bf(o);
  }
  __syncthreads();
}

DEV void gdn_decode_item(const Params& p, int item) {
  char* ws = p.ws;
  const u16* P1 = (const u16*)(ws + WS_P1);
  u16* BR = (u16*)(p.out);
  int h = item & 3, b = item >> 2;
  int tid = threadIdx.x, lane = tid & 63, wid = tid >> 6;
  float* qkv = (float*)smem;
  float* red = qkv + 1536;
  float* os = red + 512;
  float* sg = os + 512;
  float* rn = sg + 8;
  __syncthreads();
  if (tid < 384) {
    int part = tid >> 7, d = tid & 127, ch = part * 512 + h * 128 + d;
    float xr[7];
#pragma unroll
    for (int r = 0; r < 3; ++r) xr[r] = p.state_conv[((size_t)b * 3 + r) * 1536 + ch];
#pragma unroll
    for (int t = 0; t < 4; ++t) xr[3 + t] = bf2f(P1[((size_t)TP + b * 4 + t) * NP1 + C_QKVB + ch]);
    float cw[4];
#pragma unroll
    for (int j = 0; j < 4; ++j) cw[j] = p.gdn_conv_w[j * 1536 + ch];
#pragma unroll
    for (int t = 0; t < 4; ++t) {
      float s = xr[t] * cw[0] + xr[t + 1] * cw[1] + xr[t + 2] * cw[2] + xr[t + 3] * cw[3];
      qkv[(t * 3 + part) * 128 + d] = siluf_(s);
    }
#pragma unroll
    for (int r = 0; r < 3; ++r) p.out[OFF_CVS + ((size_t)b * 3 + r) * 1536 + ch] = xr[4 + r];
  } else if (tid < 388) {
    int t = tid - 384;
    const float* ba = (const float*)(ws + WS_BA) + ((size_t)TP + b * 4 + t) * 8;
    sg[4 + t] = sigmoidf_(ba[h]);
    sg[t] = -__expf(p.gdn_a_log[h]) * softplusf_(ba[4 + h] + p.gdn_dt_bias[h]);
  }
  __syncthreads();
  {
    int t = wid >> 1, which = wid & 1;
    float* v = qkv + (t * 3 + which) * 128;
    float a = v[lane], c = v[lane + 64];
    float ss = wave_sum(a * a + c * c);
    float rs = rsqrtf(ss + EPS) * (which ? 1.f : 0.08838834764831845f);
    v[lane] = a * rs; v[lane + 64] = c * rs;
  }
  int dv = tid & 127, dkq = tid >> 7;
  float S[32];
  const float* sp = p.state_rec + ((size_t)item * 128 + dkq * 32) * 128 + dv;
#pragma unroll
  for (int r = 0; r < 32; ++r) S[r] = sp[r * 128];
  __syncthreads();
#pragma unroll 1
  for (int t = 0; t < 4; ++t) {
    const float* qv = qkv + (t * 3 + 0) * 128 + dkq * 32;
    const float* kv = qkv + (t * 3 + 1) * 128 + dkq * 32;
    float vv = qkv[(t * 3 + 2) * 128 + dv];
    float a = __expf(sg[t]), beta = sg[4 + t];
    float part = 0.f;
#pragma unroll
    for (int r = 0; r < 32; ++r) part += S[r] * kv[r];
    red[dkq * 128 + dv] = part;
    __syncthreads();
    float sk = red[dv] + red[128 + dv] + red[256 + dv] + red[384 + dv];
    float vnew = beta * (vv - a * sk);
    __syncthreads();
    float po = 0.f;
#pragma unroll
    for (int r = 0; r < 32; ++r) { S[r] = a * S[r] + kv[r] * vnew; po += S[r] * qv[r]; }
    red[dkq * 128 + dv] = po;
    __syncthreads();
    if (dkq == 0) os[t * 128 + dv] = red[dv] + red[128 + dv] + red[256 + dv] + red[384 + dv];
    __syncthreads();
  }
  float* rp = p.out + OFF_RECS + ((size_t)item * 128 + dkq * 32) * 128 + dv;
#pragma unroll
  for (int r = 0; r < 32; ++r) rp[r * 128] = S[r];
  if (wid < 4) {
    float a = os[wid * 128 + lane], c = os[wid * 128 + lane + 64];
    float ss = wave_sum(a * a + c * c);
    if (lane == 0) rn[wid] = rsqrtf(ss * (1.f / 128.f) + EPS);
  }
  __syncthreads();
  {
    int t = tid >> 7, d = tid & 127;
    size_t tok = (size_t)TP + b * 4 + t;
    float z = bf2f(P1[tok * NP1 + C_ZB + h * 128 + d]);
    float o = os[t * 128 + d] * rn[t] * p.gdn_norm_w[d] * siluf_(z);
    BR[tok * 1536 + 512 + h * 128 + d] = f2bf(o);
  }
  __syncthreads();
}

DEV void rowpass1(const Params& p) {
  char* ws = p.ws;
  int wid = threadIdx.x >> 6, lane = threadIdx.x & 63;
  for (int it = blockIdx.x; it < TT / 8; it += gridDim.x) {
    int r = it * 8 + wid;
    const float* xs = r < TP ? p.x_prompt + (size_t)r * DM : p.x_sample + (size_t)(r - TP) * DM;
    const u16* mx = (const u16*)(ws + WS_MIX) + (size_t)r * DM;
    float mv[4][4];
    float ss = 0.f;
#pragma unroll
    for (int i = 0; i < 4; ++i) {
      if (r < TP) {
        uint2 w = ((const uint2*)mx)[lane + 64 * i];
        mv[i][0] = bflo(w.x); mv[i][1] = bfhi(w.x); mv[i][2] = bflo(w.y); mv[i][3] = bfhi(w.y);
      } else {
        float4 w = make_float4(0.f, 0.f, 0.f, 0.f);
#pragma unroll
        for (int ks = 0; ks < 4; ++ks) {
          float4 q = ((const float4*)((const float*)(ws + WS_ACC6) + ((size_t)ks * TSMP + (r - TP)) * DM))[lane + 64 * i];
          w.x += q.x; w.y += q.y; w.z += q.z; w.w += q.w;
        }
        mv[i][0] = w.x; mv[i][1] = w.y; mv[i][2] = w.z; mv[i][3] = w.w;
      }
      ss += mv[i][0] * mv[i][0] + mv[i][1] * mv[i][1] + mv[i][2] * mv[i][2] + mv[i][3] * mv[i][3];
    }
    ss = wave_sum(ss);
    float rstd = rsqrtf(ss * (1.f / DM) + EPS);
    float x1[4][4];
    float s2 = 0.f;
#pragma unroll
    for (int i = 0; i < 4; ++i) {
      float4 xv = ((const float4*)xs)[lane + 64 * i];
      float4 g = ((const float4*)p.ln_mix_post)[lane + 64 * i];
      x1[i][0] = xv.x + mv[i][0] * rstd * g.x; x1[i][1] = xv.y + mv[i][1] * rstd * g.y;
      x1[i][2] = xv.z + mv[i][2] * rstd * g.z; x1[i][3] = xv.w + mv[i][3] * rstd * g.w;
      s2 += x1[i][0] * x1[i][0] + x1[i][1] * x1[i][1] + x1[i][2] * x1[i][2] + x1[i][3] * x1[i][3];
      ((float4*)(p.out + (size_t)r * DM))[lane + 64 * i] = make_float4(x1[i][0], x1[i][1], x1[i][2], x1[i][3]);
    }
    s2 = wave_sum(s2);
    float r2 = rsqrtf(s2 * (1.f / DM) + EPS);
    u16* hd = (u16*)(ws + WS_H) + (size_t)r * DM;
#pragma unroll
    for (int i = 0; i < 4; ++i) {
      float4 g = ((const float4*)p.ln_ffn_pre)[lane + 64 * i];
      uint2 w; w.x = pack2(x1[i][0] * r2 * g.x, x1[i][1] * r2 * g.y); w.y = pack2(x1[i][2] * r2 * g.z, x1[i][3] * r2 * g.w);
      ((uint2*)hd)[lane + 64 * i] = w;
    }
  }
}
DEV void rowpass2(const Params& p) {
  char* ws = p.ws;
  int wid = threadIdx.x >> 6, lane = threadIdx.x & 63;
  for (int it = blockIdx.x; it < TT / 8; it += gridDim.x) {
    int r = it * 8 + wid;
    const u16* fx = (const u16*)(ws + WS_F2) + (size_t)r * DM;
    float mv[4][4];
    float ss = 0.f;
#pragma unroll
    for (int i = 0; i < 4; ++i) {
      if (r < TP) {
        uint2 w = ((const uint2*)fx)[lane + 64 * i];
        mv[i][0] = bflo(w.x); mv[i][1] = bfhi(w.x); mv[i][2] = bflo(w.y); mv[i][3] = bfhi(w.y);
      } else {
        float4 w = make_float4(0.f, 0.f, 0.f, 0.f);
#pragma unroll
        for (int ks = 0; ks < 11; ++ks) {
          float4 q = ((const float4*)((const float*)(ws + WS_ACC9) + ((size_t)ks * TSMP + (r - TP)) * DM))[lane + 64 * i];
          w.x += q.x; w.y += q.y; w.z += q.z; w.w += q.w;
        }
        mv[i][0] = w.x; mv[i][1] = w.y; mv[i][2] = w.z; mv[i][3] = w.w;
      }
      ss += mv[i][0] * mv[i][0] + mv[i][1] * mv[i][1] + mv[i][2] * mv[i][2] + mv[i][3] * mv[i][3];
    }
    ss = wave_sum(ss);
    float rstd = rsqrtf(ss * (1.f / DM) + EPS);
    float4* yo = (float4*)(p.out + (size_t)r * DM);
#pragma unroll
    for (int i = 0; i < 4; ++i) {
      float4 xv = yo[lane + 64 * i];
      float4 g = ((const float4*)p.ln_ffn_post)[lane + 64 * i];
      xv.x += mv[i][0] * rstd * g.x; xv.y += mv[i][1] * rstd * g.y; xv.z += mv[i][2] * rstd * g.z; xv.w += mv[i][3] * rstd * g.w;
      yo[lane + 64 * i] = xv;
    }
  }
}

constexpr size_t GX_OFF = (size_t)TT * 1536 * 2;
DEV u16* gate_ptr(char* ws, char* p_out_base, int row, int c) {
  if (row >= TP) return (u16*)(ws + WS_GSMP) + (size_t)(row - TP) * NGATE + c;
  u16* base = (u16*)(ws + WS_P1) + (size_t)row * NP1;
  if (c < 1536) return base + 768 + c;
  if (c < 2304) return base + (c - 1536);
  if (c < 2816) return base + 2816 + (c - 2304);
  return (u16*)(p_out_base + GX_OFF) + (size_t)row * 256 + (c - 2816);
}
DEV void gate_tile(const Params& p, int pm, int pn, bool pre, GNext nx) {
  char* ws = p.ws;
  gemm_tile((const u16*)(ws + WS_H), 1024, (const u16*)(ws + WS_WIN) + (size_t)NP1 * 1024, 1024, 1024, pm * 256, pn * 256, pre, nx,
            [&](AccRef acc, int r0, int c0) {
              EPI_LOOP(ai, bj, m, n) {
                int row = r0 + ai * 128 + m * 16, col = c0 + bj * 128 + n * 16;
                f32x4 v = acc[ai][bj][m][n];
                f32x4 sg = {sigmoidf_(v[0]), sigmoidf_(v[1]), sigmoidf_(v[2]), sigmoidf_(v[3])};
                store_bf4(gate_ptr(ws, (char*)p.out, row, col), sg);
              }
            });
}

DEV void gate_item(const Params& p, int it) {
  int pm, pn;
  if (it < 768) tile_map(it, 128, 6, pm, pn);
  else { int s2 = it - 768; pm = 128 + s2 / 12; pn = s2 % 12; }
  GNext nx;
  nx.A = nullptr; nx.B = nullptr; nx.brow = 0; nx.bcol = 0; nx.valid = 0;
  gate_tile(p, pm, pn, false, nx);
}

DEV void gate_item2(const Params& p, int it) {
  int pm, pn; tile_map(it, 128, 6, pm, pn);
  GNext nx;
  nx.A = nullptr; nx.B = nullptr; nx.brow = 0; nx.bcol = 0; nx.valid = 0;
  gate_tile(p, pm, pn + 6, false, nx);
}

constexpr int NSCAN = 32;
__global__ void __launch_bounds__(512) fwd_megakernel(Params p) {
  char* ws = p.ws;
  const int G = gridDim.x, bid = blockIdx.x;
  const int lo = (int)p.ph_lo, hi = (int)p.ph_hi;
#ifndef ONLY_PH
#define ONLY_PH -1
#endif
#ifndef REP_MASK
#define REP_MASK 0
#endif
#define PH(k) if ((ONLY_PH < 0 || ONLY_PH == (k)) && lo <= (k) && (k) < hi) for (int rep_ = 0; rep_ <= (((REP_MASK) >> (k)) & 1); ++rep_)
#define SYNC(k) if (lo <= (k) && (k) + 1 < hi) { cg::this_grid().sync(); }
  PH(0) phase_prep(p);
  SYNC(0)
  PH(1) gemm_p1_phase(p);
  SYNC(1)
  PH(2) for (int it = bid; it < 2048; it += G) gdn_pre_item(p, it);
  SYNC(2)
  PH(3) {
#ifndef ONLY_SUB
#define ONLY_SUB -1
#endif
#ifndef SUB_MASK
#define SUB_MASK 63
#endif
#define SUB(k) (((SUB_MASK) >> (k)) & 1)
#ifndef REP_SUB
#define REP_SUB 0
#endif
#ifndef REP_SCAN
#define REP_SCAN 0
#endif
    if (bid < NSCAN) gdn_scan<0>(p, bid);
    {
      unsigned* ctr = (unsigned*)(ws + WS_CTR);
      volatile int* slot = (volatile int*)(smem + LDS_BYTES - 16);
#define QUEUE_LOOP(k_, n_, body_)                                        \
  for (;;) {                                                             \
    __syncthreads();                                                     \
    if (threadIdx.x == 0) *slot = (int)atomicAdd(ctr + (k_), 1u);        \
    __syncthreads();                                                     \
    const int it = *slot;                                                \
    if (it >= (n_)) break;                                               \
    body_;                                                               \
  }
      QUEUE_LOOP(0, 792, gate_item(p, it))
      QUEUE_LOOP(1, 512, { attn_item<true>(p, it); if (threadIdx.x == 0) atomicAdd(ctr + 9, 1u); })
      QUEUE_LOOP(2, 512, { attn_item<false>(p, it); if (threadIdx.x == 0) atomicAdd(ctr + 9, 1u); })
      QUEUE_LOOP(3, 128, swa_decode_item(p, it))
      QUEUE_LOOP(4, 512, mem_decode_item(p, it))
      QUEUE_LOOP(5, 512, gdn_decode_item(p, it))
      if (threadIdx.x == 0) { while (__hip_atomic_load(ctr + 9, __ATOMIC_RELAXED, __HIP_MEMORY_SCOPE_AGENT) < 1024u) __builtin_amdgcn_s_sleep(8); }
      __syncthreads();
      QUEUE_LOOP(7, 768, gate_item2(p, it))
#undef QUEUE_LOOP
    }
  }
  SYNC(3)
#ifdef PROBE_SCAN_MODE
  PH(3) { if (bid < NSCAN) gdn_scan<PROBE_SCAN_MODE>(p, bid); }
  SYNC(3)
#endif
  PH(4) gdn_finalize(p);
  SYNC(4)
  PH(5) {
    u16* stash = (u16*)(ws + WS_STASH);
    const u16* BR = (const u16*)p.out;
    bool pre = false;
    for (int t = bid; t < 520; t += G) {
      int pm, pn; tile_map(t, 130, 4, pm, pn);
#pragma unroll 1
      for (int nbr = 0; nbr < 3; ++nbr) {
        GNext nx{nullptr, nullptr, pm * 256, pn * 256, 0};
        if (nbr < 2) { nx.A = BR + (nbr + 1) * 512; nx.B = (const u16*)(ws + WS_WBR) + (size_t)(nbr + 1) * 1024 * 512; nx.valid = 1; }
        else if (t + G < 520) { int qm, qn; tile_map(t + G, 130, 4, qm, qn); nx.A = BR; nx.B = (const u16*)(ws + WS_WBR); nx.brow = qm * 256; nx.bcol = qn * 256; nx.valid = 1; }
        const bool pre_now = pre; pre = nx.valid;
        gemm_tile(BR + nbr * 512, 1536, (const u16*)(ws + WS_WBR) + (size_t)nbr * 1024 * 512, 512, 512, pm * 256, pn * 256, pre_now, nx,
                  [&](AccRef acc, int r0, int c0) {
                    EPI_LOOP(ai, bj, m, n) {
                      int row = r0 + ai * 128 + m * 16, col = c0 + bj * 128 + n * 16;
                      f32x4 v = acc[ai][bj][m][n];
                      uint2 gw = *(const uint2*)gate_ptr(ws, (char*)p.out, row, nbr * 1024 + col);
                      f32x4 r = {v[0] * bflo(gw.x), v[1] * bfhi(gw.x), v[2] * bflo(gw.y), v[3] * bfhi(gw.y)};
                      u16* sp = stash + (size_t)row * DM + col;
                      if (nbr > 0) {
                        uint2 sw = *(const uint2*)sp;
                        r[0] += bflo(sw.x); r[1] += bfhi(sw.x); r[2] += bflo(sw.y); r[3] += bfhi(sw.y);
                      }
                      store_bf4(sp, r);
                    }
                  });
      }
    }
  }
  SYNC(5)
  PH(6) {
    u16* mix = (u16*)(ws + WS_MIX);
    float* acc6 = (float*)(ws + WS_ACC6);
    bool pre = false;
    for (int t = bid; t < 544; t += G) {
      if (t < 512) {
        int pm, pn; tile_map(t, 128, 4, pm, pn);
        GNext nx{(const u16*)(ws + WS_STASH), (const u16*)(ws + WS_WOUT), 0, 0, 0};
        if (t + G < 512) { int qm, qn; tile_map(t + G, 128, 4, qm, qn); nx.brow = qm * 256; nx.bcol = qn * 256; nx.valid = 1; }
        const bool pre_now = pre; pre = nx.valid;
        gemm_tile((const u16*)(ws + WS_STASH), 1024, (const u16*)(ws + WS_WOUT), 1024, 1024, pm * 256, pn * 256, pre_now, nx,
                  [&](AccRef acc, int r0, int c0) {
                    EPI_LOOP(ai, bj, m, n) {
                      int row = r0 + ai * 128 + m * 16, col = c0 + bj * 128 + n * 16;
                      store_bf4(mix + (size_t)row * DM + col, acc[ai][bj][m][n]);
                    }
                  });
      } else {
        const int s2 = t - 512, tl = s2 >> 2, ks = s2 & 3, pm = 128 + (tl >> 2), pn = tl & 3;
        gemm_tile((const u16*)(ws + WS_STASH) + ks * 256, 1024, (const u16*)(ws + WS_WOUT) + ks * 256, 1024, 256, pm * 256, pn * 256, false,
                  GNext{nullptr, nullptr, 0, 0, 0},
                  [&](AccRef acc, int r0, int c0) {
                    EPI_LOOP(ai, bj, m, n) {
                      int row = r0 + ai * 128 + m * 16 - TP, col = c0 + bj * 128 + n * 16;
                      float* d = acc6 + ((size_t)ks * TSMP + row) * DM + col;
                      f32x4 v = acc[ai][bj][m][n];
                      *(float4*)d = make_float4(v[0], v[1], v[2], v[3]);
                    }
                  });
        pre = false;
      }
    }
  }
  SYNC(6)
  PH(7) rowpass1(p);
  SYNC(7)
  PH(8) {
    u16* F1 = (u16*)(ws + WS_P1);
    bool pre = false;
    for (int t = bid; t < 2860; t += G) {
      int pm, pn; tile_map(t, 130, 22, pm, pn);
      GNext nx{(const u16*)(ws + WS_H), (const u16*)(ws + WS_WF1), 0, 0, 0};
      if (t + G < 2860) { int qm, qn; tile_map(t + G, 130, 22, qm, qn); nx.brow = qm * 256; nx.bcol = qn * 256; nx.valid = 1; }
      const bool pre_now = pre; pre = nx.valid;
      gemm_tile((const u16*)(ws + WS_H), 1024, (const u16*)(ws + WS_WF1), 1024, 1024, pm * 256, pn * 256, pre_now, nx,
                [&](AccRef acc, int r0, int c0) {
                  int cbase = pn * 128 + (c0 - pn * 256);
                  _Pragma("unroll") for (int ai = 0; ai < 2; ++ai) _Pragma("unroll") for (int m = 0; m < 4; ++m) _Pragma("unroll") for (int n = 0; n < 2; ++n) {
                    int row = r0 + ai * 128 + m * 16, col = cbase + n * 16;
                    f32x4 g = acc[ai][0][m][n], u = acc[ai][1][m][n];
                    f32x4 r = {siluf_(g[0]) * u[0], siluf_(g[1]) * u[1], siluf_(g[2]) * u[2], siluf_(g[3]) * u[3]};
                    store_bf4(F1 + (size_t)row * DFF + col, r);
                  }
                });
    }
  }
  SYNC(8)
  PH(9) {
    u16* F2 = (u16*)(ws + WS_F2);
    float* acc9 = (float*)(ws + WS_ACC9);
    bool pre = false;
    for (int t = bid; t < 600; t += G) {
      if (t < 512) {
        int pm, pn; tile_map(t, 128, 4, pm, pn);
        GNext nx{(const u16*)(ws + WS_P1), (const u16*)(ws + WS_WF2), 0, 0, 0};
        if (t + G < 512) { int qm, qn; tile_map(t + G, 128, 4, qm, qn); nx.brow = qm * 256; nx.bcol = qn * 256; nx.valid = 1; }
        const bool pre_now = pre; pre = nx.valid;
        gemm_tile((const u16*)(ws + WS_P1), DFF, (const u16*)(ws + WS_WF2), DFF, DFF, pm * 256, pn * 256, pre_now, nx,
                  [&](AccRef acc, int r0, int c0) {
                    EPI_LOOP(ai, bj, m, n) {
                      int row = r0 + ai * 128 + m * 16, col = c0 + bj * 128 + n * 16;
                      store_bf4(F2 + (size_t)row * DM + col, acc[ai][bj][m][n]);
                    }
                  });
      } else {
        const int s2 = t - 512, tl = s2 / 11, ks = s2 % 11, pm = 128 + (tl >> 2), pn = tl & 3;
        gemm_tile((const u16*)(ws + WS_P1) + ks * 256, DFF, (const u16*)(ws + WS_WF2) + ks * 256, DFF, 256, pm * 256, pn * 256, false,
                  GNext{nullptr, nullptr, 0, 0, 0},
                  [&](AccRef acc, int r0, int c0) {
                    EPI_LOOP(ai, bj, m, n) {
                      int row = r0 + ai * 128 + m * 16 - TP, col = c0 + bj * 128 + n * 16;
                      float* d = acc9 + ((size_t)ks * TSMP + row) * DM + col;
                      f32x4 v = acc[ai][bj][m][n];
                      *(float4*)d = make_float4(v[0], v[1], v[2], v[3]);
                    }
                  });
        pre = false;
      }
    }
  }
  SYNC(9)
  PH(10) rowpass2(p);
}

extern "C" void kernel_launch(void* const* d_in, const int* in_sizes, int n_in, void* d_out, int out_size, void* d_ws,
                              size_t ws_size, hipStream_t stream) {
  static int grid_blocks = 0;
  if (grid_blocks == 0) {
    if (n_in != 25 || (size_t)out_size != OUT_TOTAL || ws_size < WS_END) {
      fprintf(stderr, "kernel_launch: unexpected sizes n_in=%d out=%d ws=%zu (need %zu)\n", n_in, out_size, ws_size, (size_t)WS_END);
      grid_blocks = -1;
      return;
    }
    int dev = 0, cus = 0, per_cu = 0;
    hipGetDevice(&dev);
    hipDeviceGetAttribute(&cus, hipDeviceAttributeMultiprocessorCount, dev);
    hipFuncSetAttribute((const void*)fwd_megakernel, hipFuncAttributeMaxDynamicSharedMemorySize, LDS_BYTES);
    hipOccupancyMaxActiveBlocksPerMultiprocessor(&per_cu, (const void*)fwd_megakernel, 512, LDS_BYTES);
    if (per_cu < 1) { fprintf(stderr, "kernel_launch: occupancy query says 0 blocks per CU\n"); grid_blocks = -1; return; }
    grid_blocks = cus * 1;
  }
  if (grid_blocks < 0) return;
  Params p{};
  const float** pp = (const float**)&p;
  for (int i = 0; i < 25; ++i) pp[i] = (const float*)d_in[i];
  p.out = (float*)d_out;
  p.ws = (char*)d_ws;
#if N_LAUNCH_MODE == 1
#ifndef MAX_PH
#define MAX_PH 11
#endif
  p.ph_lo = 0; p.ph_hi = MAX_PH;
  void* args[] = {&p};
  hipError_t e = hipLaunchCooperativeKernel((const void*)fwd_megakernel, dim3(grid_blocks), dim3(512), args, LDS_BYTES, stream);
  if (e != hipSuccess) fprintf(stderr, "cooperative launch failed: %s (grid %d)\n", hipGetErrorString(e), grid_blocks);
#else
  for (int ph = 0; ph < 11; ++ph) {
    p.ph_lo = ph; p.ph_hi = ph + 1;
    hipLaunchKernelGGL(fwd_megakernel, dim3(grid_blocks), dim3(512), LDS_BYTES, stream, p);
  }
#endif
}
```

```cpp
#include <hip/hip_runtime.h>
#include <hip/hip_cooperative_groups.h>
#include <cstdio>
#include <cstdint>
namespace cg = cooperative_groups;

typedef unsigned short u16;
using bf16x8 = __attribute__((ext_vector_type(8))) short;
using bf16x4 = __attribute__((ext_vector_type(4))) short;
using f32x4 = __attribute__((ext_vector_type(4))) float;
#define DEV __device__ __forceinline__

#define REP_MASK 0
#ifndef N_LAUNCH_MODE
#define N_LAUNCH_MODE 1
#endif

constexpr int TP = 32768, TSMP = 512, TT = 33280, DM = 1024;
constexpr int SEQ = 8192;
constexpr int NP1 = 3328;
constexpr int C_QA = 0, C_KA = 512, C_VA = 640, C_QKVB = 768, C_ZB = 2304, C_QC = 2816;
constexpr int NGATE = 3072;
constexpr int DFF = 2816;
constexpr int WIN_LD = 6408;
constexpr float EPS = 1e-6f;

constexpr size_t OFF_Y = 0;
constexpr size_t OFF_WKP = (size_t)TT * DM;
constexpr size_t OFF_WVP = OFF_WKP + 65536;
constexpr size_t OFF_CVP = OFF_WVP + 65536;
constexpr size_t OFF_RECP = OFF_CVP + 18432;
constexpr size_t OFF_MKP = OFF_RECP + 262144;
constexpr size_t OFF_MVP = OFF_MKP + 524288;
constexpr size_t OFF_WKS = OFF_MVP + 524288;
constexpr size_t OFF_WVS = OFF_WKS + 2097152;
constexpr size_t OFF_CVS = OFF_WVS + 2097152;
constexpr size_t OFF_RECS = OFF_CVS + 589824;
constexpr size_t OUT_TOTAL = OFF_RECS + 8388608;

constexpr size_t al256(size_t x) { return (x + 255) & ~(size_t)255; }
constexpr size_t WS_WIN = 0;
constexpr size_t WS_WMEM = WS_WIN + (size_t)6400 * 1024 * 2;
constexpr size_t WS_WBR = WS_WMEM + (size_t)1024 * 1024 * 2;
constexpr size_t WS_WOUT = WS_WBR + (size_t)3 * 1024 * 512 * 2;
constexpr size_t WS_WF1 = WS_WOUT + (size_t)1024 * 1024 * 2;
constexpr size_t WS_WF2 = WS_WF1 + (size_t)5632 * 1024 * 2;
constexpr size_t WS_H = WS_WF2 + (size_t)1024 * 2816 * 2;
constexpr size_t WS_P1 = WS_H + (size_t)TT * 1024 * 2;
constexpr size_t WS_GS = WS_P1 + (size_t)TT * NP1 * 2;
constexpr size_t GS_ITEM = 36864;
constexpr size_t WS_MISC = WS_GS + (size_t)2048 * GS_ITEM * 2;
constexpr size_t WS_BA = WS_MISC;
constexpr size_t WS_ROPE = WS_BA + (size_t)TT * 8 * 4;
constexpr size_t WS_HMEM = al256(WS_ROPE + (size_t)8196 * 32 * 8);
constexpr size_t WS_MEMKV = WS_HMEM + (size_t)1024 * 1024 * 2;
constexpr size_t WS_GAM = WS_MEMKV + (size_t)1024 * 1024 * 2;
constexpr size_t WS_SSQ = WS_GAM + 2048 * 4;
constexpr size_t WS_GSMP = WS_SSQ + (size_t)TP * 4 * 8 * 4;
constexpr size_t WS_CTR = WS_GSMP + (size_t)TSMP * NGATE * 2;
constexpr size_t WS_ACC6 = WS_CTR + 256;
constexpr size_t WS_ACC9 = WS_ACC6 + (size_t)4 * TSMP * DM * 4;
constexpr size_t WS_END = WS_ACC9 + (size_t)11 * TSMP * DM * 4;
constexpr size_t WS_STASH = WS_GS;
constexpr size_t WS_MIX = WS_GS + (size_t)TT * 1024 * 2;
constexpr size_t WS_F2 = WS_GS;

constexpr int LDS_BYTES = 160 * 1024;

struct Params {
  const float *x_prompt, *x_sample, *mem_prompt, *state_win_k, *state_win_v, *state_conv, *state_rec, *cache_mem_k, *cache_mem_v;
  const float *ln_mix_pre, *w_in, *attn_sink, *gdn_conv_w, *gdn_a_log, *gdn_dt_bias, *gdn_norm_w, *ln_mem, *w_mem_kv, *w_branch,
      *w_out, *ln_mix_post, *ln_ffn_pre, *w_ffn_in, *w_ffn_out, *ln_ffn_post;
  float* out;
  char* ws;
  long long ph_lo, ph_hi;
};

extern __shared__ __attribute__((aligned(16))) char smem[];

__device__ const float ROPE_INV[32] = {
    1.0f, 0.7498942093324559f, 0.5623413251903491f, 0.4216965034285822f, 0.31622776601683794f, 0.23713737056616552f,
    0.1778279410038923f, 0.1333521432163324f, 0.1f, 0.07498942093324558f, 0.05623413251903491f, 0.042169650342858224f,
    0.03162277660168379f, 0.023713737056616554f, 0.01778279410038923f, 0.01333521432163324f, 0.01f, 0.007498942093324558f,
    0.005623413251903491f, 0.004216965034285823f, 0.0031622776601683794f, 0.0023713737056616554f, 0.0017782794100389228f,
    0.001333521432163324f, 0.001f, 0.0007498942093324559f, 0.0005623413251903491f, 0.00042169650342858224f,
    0.00031622776601683794f, 0.00023713737056616554f, 0.00017782794100389227f, 0.0001333521432163324f};

typedef __bf16 hbf2 __attribute__((ext_vector_type(2)));
typedef float hf2 __attribute__((ext_vector_type(2)));
DEV unsigned pack2(float a, float b) {
  hf2 v = {a, b};
  hbf2 r = __builtin_convertvector(v, hbf2);
  return __builtin_bit_cast(unsigned, r);
}
DEV u16 f2bf(float f) { return (u16)(pack2(f, 0.f) & 0xffffu); }
DEV float bf2f(u16 h) { return __uint_as_float(((unsigned)h) << 16); }
DEV float row16_sum(float s) {
  s += __builtin_bit_cast(float, __builtin_amdgcn_update_dpp(0, __builtin_bit_cast(int, s), 0xB1, 0xf, 0xf, true));
  s += __builtin_bit_cast(float, __builtin_amdgcn_update_dpp(0, __builtin_bit_cast(int, s), 0x4E, 0xf, 0xf, true));
  s += __builtin_bit_cast(float, __builtin_amdgcn_update_dpp(0, __builtin_bit_cast(int, s), 0x124, 0xf, 0xf, true));
  s += __builtin_bit_cast(float, __builtin_amdgcn_update_dpp(0, __builtin_bit_cast(int, s), 0x128, 0xf, 0xf, true));
  return s;
}
DEV float bflo(unsigned w) { return __uint_as_float(w << 16); }
DEV float bfhi(unsigned w) { return __uint_as_float(w & 0xffff0000u); }
DEV void unpack8(uint4 v, float* o) {
  o[0] = bflo(v.x); o[1] = bfhi(v.x); o[2] = bflo(v.y); o[3] = bfhi(v.y);
  o[4] = bflo(v.z); o[5] = bfhi(v.z); o[6] = bflo(v.w); o[7] = bfhi(v.w);
}
DEV uint4 pack8(const float* o) {
  uint4 v; v.x = pack2(o[0], o[1]); v.y = pack2(o[2], o[3]); v.z = pack2(o[4], o[5]); v.w = pack2(o[6], o[7]);
  return v;
}
DEV float sigmoidf_(float x) { return __builtin_amdgcn_rcpf(1.f + __expf(-x)); }
DEV float siluf_(float x) { return x * __builtin_amdgcn_rcpf(1.f + __expf(-x)); }
DEV float wave_sum(float v) {
#pragma unroll
  for (int o = 32; o > 0; o >>= 1) v += __shfl_xor(v, o);
  return v;
}
DEV bf16x8 mk8(bf16x4 lo, bf16x4 hi) { return __builtin_shufflevector(lo, hi, 0, 1, 2, 3, 4, 5, 6, 7); }
DEV bf16x8 pack_acc2(f32x4 a, f32x4 b) {
  union { unsigned u[4]; bf16x8 v; } x;
  x.u[0] = pack2(a[0], a[1]); x.u[1] = pack2(a[2], a[3]); x.u[2] = pack2(b[0], b[1]); x.u[3] = pack2(b[2], b[3]);
  return x.v;
}
#define MFMA16(a, b, c) __builtin_amdgcn_mfma_f32_16x16x32_bf16((a), (b), (c), 0, 0, 0)

constexpr int G_BK = 64, G_HALF = 128, G_HT = G_HALF * G_BK;
DEV int lds_byte(int r, int c) {
  int st = (r >> 4) * 2 + (c >> 5), rr = r & 15, cc = c & 31, ob = rr * 64 + cc * 2;
  return st * 1024 + (ob ^ (((ob >> 9) & 1) << 5));
}
DEV void stage_rc(int b, int& R, int& C) {
  int st = b / 1024, sb = b % 1024, swz = sb ^ (((sb >> 9) & 1) << 5);
  R = (st >> 1) * 16 + swz / 64;
  C = (st & 1) * 32 + (swz % 64) / 2;
}

#define LAS __attribute__((address_space(3)))
struct GNext { const u16* A; const u16* B; int brow, bcol, valid; };
template <class Epi>
DEV void gemm_tile(const u16* __restrict__ A, int lda, const u16* __restrict__ Bt, int ldb, int K, int brow, int bcol, bool pre_issued, GNext nx, Epi epi) {
  LAS unsigned char* lds = (LAS unsigned char*)smem;
  constexpr int HTB = G_HT * 2;
  const int tid = threadIdx.x, wid = __builtin_amdgcn_readfirstlane(tid >> 6), lane = tid & 63, wr = wid >> 2, wc = wid & 3, fr = lane & 15, fq = lane >> 4;
  unsigned voffA[2], voffB[2];
#pragma unroll
  for (int i = 0; i < 2; ++i) {
    int R, C;
    stage_rc(tid * 16 + i * 8192, R, C);
    const int rho = R & 31, Rb = (R & ~31) + 8 * ((rho & 15) >> 2) + 4 * (rho >> 4) + (rho & 3);
    voffA[i] = (unsigned)(R * lda + C) * 2u;
    voffB[i] = (unsigned)(Rb * ldb + C) * 2u;
  }
  const size_t kstep = (size_t)(G_BK * 2);
  const size_t hstepA = (size_t)G_HALF * lda * 2, hstepB = (size_t)G_HALF * ldb * 2;
  const unsigned ldsw = (unsigned)wid * 1024u;
  const int aoff = lds_byte(wr * 64 + fr, fq * 8), boff = lds_byte(wc * 32 + fr, fq * 8);
  const char* cA = (const char*)A + (size_t)brow * lda * 2;
  const char* cB = (const char*)Bt + (size_t)bcol * ldb * 2;
#define SA(b, h) (((b)*2 + (h)) * HTB)
#define SB(b, h) ((4 + (b)*2 + (h)) * HTB)
#define STAGE(bufoff, gbase, voff)                                                                                      \
  do {                                                                                                                  \
    _Pragma("unroll") for (int _i = 0; _i < 2; ++_i) __builtin_amdgcn_global_load_lds(                                  \
        (const unsigned*)((const char*)(gbase) + (voff)[_i]), (LAS unsigned*)(lds + (bufoff) + ldsw + _i * 8192), 16, 0, 0); \
  } while (0)
#define LDA(dst, b, h)                                                                                                  \
  do {                                                                                                                  \
    _Pragma("unroll") for (int m = 0; m < 4; ++m) _Pragma("unroll") for (int k = 0; k < 2; ++k) dst[m][k] =             \
        *(const LAS bf16x8*)(lds + SA(b, h) + aoff + m * 2048 + k * 1024);                                              \
  } while (0)
#define LDB(dst, b, h)                                                                                                  \
  do {                                                                                                                  \
    _Pragma("unroll") for (int n = 0; n < 2; ++n) _Pragma("unroll") for (int k = 0; k < 2; ++k) dst[n][k] =             \
        *(const LAS bf16x8*)(lds + SB(b, h) + boff + n * 2048 + k * 1024);                                              \
  } while (0)
#define MMA(ai, bj, At_, Bt_)                                                                                           \
  do {                                                                                                                  \
    __builtin_amdgcn_s_setprio(1);                                                                                      \
    _Pragma("unroll") for (int m = 0; m < 4; ++m) _Pragma("unroll") for (int n = 0; n < 2; ++n)                         \
        _Pragma("unroll") for (int k = 0; k < 2; ++k) acc[ai][bj][m][n] = MFMA16(Bt_[n][k], At_[m][k], acc[ai][bj][m][n]); \
    __builtin_amdgcn_s_setprio(0);                                                                                      \
  } while (0)
#define WAIT_V(n) asm volatile("s_waitcnt vmcnt(" #n ")" ::: "memory")
#define WAIT_L(n) asm volatile("s_waitcnt lgkmcnt(" #n ")" ::: "memory")
#define BAR __builtin_amdgcn_s_barrier()
#define SCHED __builtin_amdgcn_sched_barrier(0)
  f32x4 acc[2][2][4][2];
#pragma unroll
  for (int a = 0; a < 2; ++a)
#pragma unroll
    for (int b = 0; b < 2; ++b)
#pragma unroll
      for (int m = 0; m < 4; ++m)
#pragma unroll
        for (int n = 0; n < 2; ++n) acc[a][b][m][n] = (f32x4){0.f, 0.f, 0.f, 0.f};
  bf16x8 At[4][2], B0[2][2], B1[2][2];
  const int nt = K / G_BK;
  if (!pre_issued) {
    WAIT_V(0);
    __syncthreads();
    STAGE(SB(0, 0), cB, voffB); STAGE(SA(0, 0), cA, voffA); STAGE(SB(0, 1), cB + hstepB, voffB); STAGE(SA(0, 1), cA + hstepA, voffA);
  }
  if (wr == 1) BAR;
  WAIT_V(4); BAR;
  STAGE(SB(1, 0), cB + kstep, voffB); STAGE(SA(1, 0), cA + kstep, voffA); STAGE(SB(1, 1), cB + hstepB + kstep, voffB);
  WAIT_V(6); BAR;
#pragma unroll 1
  for (int t = 0; t < nt - 2; t += 2) {
    const char* a1 = cA + (size_t)(t + 1) * kstep;
    const char* a2 = cA + (size_t)(t + 2) * kstep; const char* b2 = cB + (size_t)(t + 2) * kstep;
    const char* a3 = a2 + kstep; const char* b3 = b2 + kstep;
    LDB(B0, 0, 0); SCHED; LDA(At, 0, 0); STAGE(SA(1, 1), a1 + hstepA, voffA);
    WAIT_L(8); BAR; WAIT_L(0); MMA(0, 0, At, B0); BAR; SCHED;
    LDB(B1, 0, 1); STAGE(SB(0, 0), b2, voffB);
    BAR; WAIT_L(0); MMA(0, 1, At, B1); BAR;
    LDA(At, 0, 1); STAGE(SA(0, 0), a2, voffA);
    BAR; WAIT_L(0); MMA(1, 0, At, B0); BAR; SCHED;
    STAGE(SB(0, 1), b2 + hstepB, voffB);
    WAIT_V(6); BAR; MMA(1, 1, At, B1); BAR;
    LDB(B0, 1, 0); SCHED; LDA(At, 1, 0); STAGE(SA(0, 1), a2 + hstepA, voffA);
    WAIT_L(8); BAR; WAIT_L(0); MMA(0, 0, At, B0); BAR; SCHED;
    LDB(B1, 1, 1); STAGE(SB(1, 0), b3, voffB);
    BAR; WAIT_L(0); MMA(0, 1, At, B1); BAR;
    LDA(At, 1, 1); STAGE(SA(1, 0), a3, voffA);
    BAR; WAIT_L(0); MMA(1, 0, At, B0); BAR; SCHED;
    STAGE(SB(1, 1), b3 + hstepB, voffB);
    WAIT_V(6); BAR; MMA(1, 1, At, B1); BAR;
  }
  { const char* a1 = cA + (size_t)(nt - 1) * kstep;
    LDB(B0, 0, 0); LDA(At, 0, 0); STAGE(SA(1, 1), a1 + hstepA, voffA);
    BAR; WAIT_L(0); MMA(0, 0, At, B0); BAR;
    LDB(B1, 0, 1); BAR; WAIT_L(0); MMA(0, 1, At, B1); BAR;
    LDA(At, 0, 1); WAIT_V(4); BAR; WAIT_L(0); MMA(1, 0, At, B0); MMA(1, 1, At, B1); BAR; }
  { LDB(B0, 1, 0); LDA(At, 1, 0); WAIT_V(2); BAR; WAIT_L(0); MMA(0, 0, At, B0); BAR;
    LDB(B1, 1, 1); WAIT_V(0); BAR; WAIT_L(0); MMA(0, 1, At, B1); BAR;
    LDA(At, 1, 1); BAR; WAIT_L(0); MMA(1, 0, At, B0); MMA(1, 1, At, B1); BAR; }
  if (wr == 0) BAR;
  if (nx.valid) {
    const char* nA = (const char*)nx.A + (size_t)nx.brow * lda * 2;
    const char* nB = (const char*)nx.B + (size_t)nx.bcol * ldb * 2;
    STAGE(SB(0, 0), nB, voffB); STAGE(SA(0, 0), nA, voffA); STAGE(SB(0, 1), nB + hstepB, voffB); STAGE(SA(0, 1), nA + hstepA, voffA);
  }
  epi(acc, brow + wr * 64 + fr, bcol + wc * 32 + fq * 8);
#undef SA
#undef SB
#undef STAGE
#undef LDA
#undef LDB
#undef MMA
}
#define EPI_LOOP(ai, bj, m, n) \
  _Pragma("unroll") for (int ai = 0; ai < 2; ++ai) _Pragma("unroll") for (int bj = 0; bj < 2; ++bj) \
  _Pragma("unroll") for (int m = 0; m < 4; ++m) _Pragma("unroll") for (int n = 0; n < 2; ++n)

typedef f32x4 (&AccRef)[2][2][4][2];

DEV void tile_map(int t, int nM, int nN, int& pm, int& pn) {
  const int NX = 8, WGM = 8;
  int nwg = nM * nN;
  int q = nwg / NX, r = nwg % NX, xcd = t % NX, off = t / NX;
  int wgid = (xcd < r ? xcd * (q + 1) : r * (q + 1) + (xcd - r) * q) + off;
  int nig = WGM * nN, gid = wgid / nig, fm = gid * WGM, gsz = min(nM - fm, WGM);
  pm = fm + ((wgid % nig) % gsz);
  pn = (wgid % nig) / gsz;
}

DEV void store_bf4(u16* dst, f32x4 v) {
  uint2 w; w.x = pack2(v[0], v[1]); w.y = pack2(v[2], v[3]);
  *(uint2*)dst = w;
}

DEV void transpose_tile(const float* __restrict__ src, int ld, int k0, int c0, u16* __restrict__ dst, int lddst, int drow0) {
  float* t = (float*)smem;
  int tid = threadIdx.x, lx = tid & 63, ly = tid >> 6;
#pragma unroll
  for (int i = 0; i < 8; ++i) { int r = ly + 8 * i; t[r * 65 + lx] = src[(size_t)(k0 + r) * ld + c0 + lx]; }
  __syncthreads();
  {
    const int j = tid >> 3, ks = tid & 7;
    float v[8];
#pragma unroll
    for (int e = 0; e < 8; ++e) v[e] = t[(ks * 8 + e) * 65 + j];
    *(uint4*)&dst[(size_t)(drow0 + j) * lddst + k0 + ks * 8] = pack8(v);
  }
  __syncthreads();
}

DEV void phase_prep(const Params& p) {
  char* ws = p.ws;
  const int G = gridDim.x;
  for (int ti = blockIdx.x; ti < 4608; ti += G) {
    if (ti < 1600) {
      int kt = ti / 100, ct = ti % 100;
      int c0 = ct * 64 < 2304 ? ct * 64 : ct * 64 + 8;
      transpose_tile(p.w_in, WIN_LD, kt * 64, c0, (u16*)(ws + WS_WIN), 1024, ct * 64);
    } else if (ti < 1856) {
      int t2 = ti - 1600, kt = t2 / 16, ct = t2 % 16;
      transpose_tile(p.w_mem_kv, 1024, kt * 64, ct * 64, (u16*)(ws + WS_WMEM), 1024, ct * 64);
    } else if (ti < 2240) {
      int t2 = ti - 1856, n = t2 / 128, r = t2 % 128, kt = r / 16, ct = r % 16;
      transpose_tile(p.w_branch + (size_t)n * 512 * 1024, 1024, kt * 64, ct * 64, (u16*)(ws + WS_WBR) + (size_t)n * 1024 * 512, 512, ct * 64);
    } else if (ti < 2496) {
      int t2 = ti - 2240, kt = t2 / 16, ct = t2 % 16;
      transpose_tile(p.w_out, 1024, kt * 64, ct * 64, (u16*)(ws + WS_WOUT), 1024, ct * 64);
    } else if (ti < 3904) {
      int t2 = ti - 2496, kt = t2 / 88, ct = t2 % 88;
      int c0 = ct * 64, drow;
      if (c0 < DFF) drow = (c0 / 128) * 256 + (c0 % 128);
      else { int c1 = c0 - DFF; drow = (c1 / 128) * 256 + 128 + (c1 % 128); }
      transpose_tile(p.w_ffn_in, 2 * DFF, kt * 64, c0, (u16*)(ws + WS_WF1), 1024, drow);
    } else {
      int t2 = ti - 3904, kt = t2 / 16, ct = t2 % 16;
      transpose_tile(p.w_ffn_out, 1024, kt * 64, ct * 64, (u16*)(ws + WS_WF2), DFF, ct * 64);
    }
  }
  if (blockIdx.x == 0 && threadIdx.x < 8) ((unsigned*)(ws + WS_CTR))[threadIdx.x] = 0u;
  {
    float2* rope = (float2*)(ws + WS_ROPE);
    for (int idx = blockIdx.x * 512 + threadIdx.x; idx < 8196 * 32; idx += G * 512) {
      int pi = idx >> 5, i = idx & 31;
      int pos = pi < 8192 ? pi : 16384 + (pi - 8192);
      float ang = (float)pos * ROPE_INV[i];
      double rev = (double)ang * 0.15915494309189535;
      float fr = (float)(rev - floor(rev));
      rope[idx] = make_float2(__builtin_amdgcn_cosf(fr), __builtin_amdgcn_sinf(fr));
    }
  }
  {
    float* wba = (float*)smem;
    __syncthreads();
    for (int i = threadIdx.x; i < 1024 * 8; i += 512) wba[i] = p.w_in[(size_t)(i >> 3) * WIN_LD + 2304 + (i & 7)];
    __syncthreads();
    int wid = threadIdx.x >> 6, lane = threadIdx.x & 63;
    for (int it = blockIdx.x; it < (TT + 1024) / 8; it += G) {
      int r = it * 8 + wid;
      const float* src; const float* gain; u16* dst;
      if (r < TP) { src = p.x_prompt + (size_t)r * DM; gain = p.ln_mix_pre; dst = (u16*)(ws + WS_H) + (size_t)r * DM; }
      else if (r < TT) { src = p.x_sample + (size_t)(r - TP) * DM; gain = p.ln_mix_pre; dst = (u16*)(ws + WS_H) + (size_t)r * DM; }
      else { src = p.mem_prompt + (size_t)(r - TT) * DM; gain = p.ln_mem; dst = (u16*)(ws + WS_HMEM) + (size_t)(r - TT) * DM; }
      float4 v[4];
      float ss = 0.f;
#pragma unroll
      for (int i = 0; i < 4; ++i) {
        v[i] = ((const float4*)src)[lane + 64 * i];
        ss += v[i].x * v[i].x + v[i].y * v[i].y + v[i].z * v[i].z + v[i].w * v[i].w;
      }
      ss = wave_sum(ss);
      float rstd = rsqrtf(ss * (1.f / DM) + EPS);
      float d8[8] = {0, 0, 0, 0, 0, 0, 0, 0};
#pragma unroll
      for (int i = 0; i < 4; ++i) {
        float4 g = ((const float4*)gain)[lane + 64 * i];
        float h0 = v[i].x * rstd * g.x, h1 = v[i].y * rstd * g.y, h2 = v[i].z * rstd * g.z, h3 = v[i].w * rstd * g.w;
        uint2 w; w.x = pack2(h0, h1); w.y = pack2(h2, h3);
        ((uint2*)dst)[lane + 64 * i] = w;
        if (r < TT) {
          int k = (lane + 64 * i) * 4;
          float hh[4] = {h0, h1, h2, h3};
#pragma unroll
          for (int e = 0; e < 4; ++e) {
            float4 wa = *(const float4*)&wba[(k + e) * 8], wb = *(const float4*)&wba[(k + e) * 8 + 4];
            d8[0] += hh[e] * wa.x; d8[1] += hh[e] * wa.y; d8[2] += hh[e] * wa.z; d8[3] += hh[e] * wa.w;
            d8[4] += hh[e] * wb.x; d8[5] += hh[e] * wb.y; d8[6] += hh[e] * wb.z; d8[7] += hh[e] * wb.w;
          }
        }
      }
      if (r < TT) {
#pragma unroll
        for (int c = 0; c < 8; ++c) d8[c] = wave_sum(d8[c]);
        if (lane == 0) {
          float* ba = (float*)(ws + WS_BA) + (size_t)r * 8;
          *(float4*)ba = make_float4(d8[0], d8[1], d8[2], d8[3]);
          *(float4*)(ba + 4) = make_float4(d8[4], d8[5], d8[6], d8[7]);
        }
      }
    }
    __syncthreads();
  }
}

DEV void gemm_p1_phase(const Params& p) {
  char* ws = p.ws;
  const int G = gridDim.x;
  bool pre = false;
  for (int t = blockIdx.x; t < 1706; t += G) {
    const int tn = t + G;
    GNext nx{nullptr, nullptr, 0, 0, 0};
    if (tn < 1706) {
      if (tn < 1690) { int pm, pn; tile_map(tn, 130, 13, pm, pn); nx = GNext{(const u16*)(ws + WS_H), (const u16*)(ws + WS_WIN), pm * 256, pn * 256, 1}; }
      else { int t2 = tn - 1690; nx = GNext{(const u16*)(ws + WS_HMEM), (const u16*)(ws + WS_WMEM), (t2 >> 2) * 256, (t2 & 3) * 256, 1}; }
    }
    if (t < 1690) {
      int pm, pn; tile_map(t, 130, 13, pm, pn);
      u16* P1 = (u16*)(ws + WS_P1);
      gemm_tile((const u16*)(ws + WS_H), 1024, (const u16*)(ws + WS_WIN), 1024, 1024, pm * 256, pn * 256, pre, nx,
                [&](AccRef acc, int r0, int c0) {
                  EPI_LOOP(ai, bj, m, n) {
                    int row = r0 + ai * 128 + m * 16, col = c0 + bj * 128 + n * 4;
                    store_bf4(P1 + (size_t)row * NP1 + col, acc[ai][bj][m][n]);
                  }
                });
    } else {
      int t2 = t - 1690, pm = t2 >> 2, pn = t2 & 3;
      u16* MK = (u16*)(ws + WS_MEMKV);
      float* out = p.out;
      gemm_tile((const u16*)(ws + WS_HMEM), 1024, (const u16*)(ws + WS_WMEM), 1024, 1024, pm * 256, pn * 256, pre, nx,
                [&](AccRef acc, int r0, int c0) {
                  EPI_LOOP(ai, bj, m, n) {
                    int row = r0 + ai * 128 + m * 16, col = c0 + bj * 128 + n * 4;
                    f32x4 v = acc[ai][bj][m][n];
                    store_bf4(MK + (size_t)row * 1024 + col, v);
                    float* o = col < 512 ? out + OFF_MKP + (size_t)row * 512 + col : out + OFF_MVP + (size_t)row * 512 + (col - 512);
                    *(float4*)o = make_float4(v[0], v[1], v[2], v[3]);
                  }
                });
    }
    pre = nx.valid;
  }
}

DEV int kperm(int k) { return (k & ~31) | (((k >> 2) & 3) << 3) | (((k >> 4) & 1) << 2) | (k & 3); }
DEV float softplusf_(float x) { return x > 20.f ? x : log1pf(__expf(x)); }

DEV void gdn_pre_item(const Params& p, int item) {
  char* ws = p.ws;
  const u16* P1 = (const u16*)(ws + WS_P1);
  int n = item & 127, bh = item >> 7, h = bh & 3, b = bh >> 2;
  int tid = threadIdx.x, lane = tid & 63, wid = tid >> 6, fr = lane & 15, fq = lane >> 4;
  float* qf = (float*)smem;
  float* kf = qf + 8192;
  float* vf = kf + 8192;
  u16* kb = (u16*)(vf + 8192);
  u16* qb = kb + 64 * 136;
  float* Am = (float*)(qb + 64 * 136);
  float* s_g = Am + 64 * 68;
  float* s_beta = s_g + 64;
  float* s_gc = s_beta + 64;
  float* s_rq = s_gc + 64;
  float* s_rk = s_rq + 64;
  float* s_fw = s_rk + 64;
  u16* gs = (u16*)(ws + WS_GS) + (size_t)item * GS_ITEM;
  u16* g_w = gs, *g_qe = gs + 8192, *g_kdT = gs + 16384, *g_uT = gs + 24576, *g_qk = gs + 32768;
  const size_t tokbase = (size_t)b * SEQ + (size_t)n * 64;

  if (tid < 384) {
    int cgp = tid % 48, tg = tid / 48, part = cgp >> 4, d0 = (cgp & 15) * 8;
    int ch = part * 512 + h * 128 + d0;
    uint4 rawp[11];
#pragma unroll
    for (int r = 0; r < 11; ++r) {
      int l = n * 64 + tg * 8 - 3 + r;
      rawp[r] = make_uint4(0, 0, 0, 0);
      if (l >= 0) rawp[r] = *(const uint4*)(P1 + ((size_t)b * SEQ + l) * NP1 + C_QKVB + ch);
    }
    float* dstb = part == 0 ? qf : (part == 1 ? kf : vf);
#pragma unroll
    for (int eh = 0; eh < 2; ++eh) {
      float cw[4][4];
#pragma unroll
      for (int j = 0; j < 4; ++j) {
        float4 a = *(const float4*)(p.gdn_conv_w + j * 1536 + ch + eh * 4);
        cw[j][0] = a.x; cw[j][1] = a.y; cw[j][2] = a.z; cw[j][3] = a.w;
      }
#pragma unroll
      for (int i = 0; i < 8; ++i) {
        float o[4];
#pragma unroll
        for (int e = 0; e < 4; ++e) {
          float s = 0.f;
#pragma unroll
          for (int j = 0; j < 4; ++j) {
            unsigned w = eh == 0 ? (e < 2 ? rawp[i + j].x : rawp[i + j].y) : (e < 2 ? rawp[i + j].z : rawp[i + j].w);
            float x = (e & 1) ? bfhi(w) : bflo(w);
            s += x * cw[j][e];
          }
          o[e] = siluf_(s);
        }
        *(float4*)(dstb + (tg * 8 + i) * 128 + d0 + eh * 4) = make_float4(o[0], o[1], o[2], o[3]);
      }
    }
    if (n == 127 && tg == 7) {
#pragma unroll
      for (int i = 5; i < 8; ++i) {
        float* o = p.out + OFF_CVP + ((size_t)b * 3 + (i - 5)) * 1536 + ch;
        float x[8];
        unpack8(rawp[i + 3], x);
        *(float4*)o = make_float4(x[0], x[1], x[2], x[3]);
        *(float4*)(o + 4) = make_float4(x[4], x[5], x[6], x[7]);
      }
    }
  } else if (tid < 448) {
    int i = tid - 384;
    const float* ba = (const float*)(ws + WS_BA) + (tokbase + i) * 8;
    float braw = ba[h], araw = ba[4 + h];
    s_beta[i] = sigmoidf_(braw);
    s_g[i] = -__expf(p.gdn_a_log[h]) * softplusf_(araw + p.gdn_dt_bias[h]);
  }
  __syncthreads();
  if (tid < 128) {
    int i = tid & 63, which = tid >> 6;
    const float* src = (which ? kf : qf) + i * 128;
    float ss = 0.f;
#pragma unroll 8
    for (int j = 0; j < 128; ++j) { float x = src[(j + lane) & 127]; ss += x * x; }
    float rs = rsqrtf(ss + EPS);
    if (which) s_rk[i] = rs; else s_rq[i] = rs * 0.08838834764831845f;
  } else if (tid < 192) {
    float v = s_g[lane];
#pragma unroll
    for (int o = 1; o < 64; o <<= 1) { float t = __shfl_up(v, o); if (lane >= o) v += t; }
    s_gc[lane] = v;
  }
  __syncthreads();
  {
    const int d2 = (tid & 63) * 2, r0 = tid >> 6;
#pragma unroll
    for (int r = 0; r < 8; ++r) {
      int i = r0 * 8 + r;
      float rq = s_rq[i], rk = s_rk[i];
      float2 qv = *(const float2*)&qf[i * 128 + d2], kv = *(const float2*)&kf[i * 128 + d2];
      *(unsigned*)&qb[i * 136 + d2] = pack2(qv.x * rq, qv.y * rq);
      *(unsigned*)&kb[i * 136 + d2] = pack2(kv.x * rk, kv.y * rk);
    }
    if (tid < 64) s_fw[tid] = s_beta[tid] * s_rk[tid] * __expf(s_gc[tid]);
  }
  __syncthreads();
#pragma unroll 1
  for (int tt = 0; tt < 4; ++tt) {
    int id = wid * 4 + tt, which = id >> 4, it = (id & 15) >> 2, jt = id & 3;
    if (jt > it) {
      if (which) {
#pragma unroll
        for (int jj = 0; jj < 4; ++jj) g_qk[(it * 16 + fq * 4 + jj) * 64 + kperm(jt * 16 + fr)] = 0;
      }
      continue;
    }
    const u16* X = which ? qb : kb;
    f32x4 acc = {0.f, 0.f, 0.f, 0.f};
#pragma unroll
    for (int ks = 0; ks < 4; ++ks) {
      bf16x8 a = *(const bf16x8*)&X[(it * 16 + fr) * 136 + ks * 32 + fq * 8];
      bf16x8 bb = *(const bf16x8*)&kb[(jt * 16 + fr) * 136 + ks * 32 + fq * 8];
      acc = MFMA16(a, bb, acc);
    }
    int j = jt * 16 + fr;
    float gj = s_gc[j];
#pragma unroll
    for (int jj = 0; jj < 4; ++jj) {
      int i = it * 16 + fq * 4 + jj;
      float dec = __expf(fminf(s_gc[i] - gj, 0.f));
      if (which) g_qk[i * 64 + kperm(j)] = f2bf(j <= i ? acc[jj] * dec : 0.f);
      else Am[i * 68 + j] = (j < i) ? s_beta[i] * acc[jj] * dec : 0.f;
    }
  }
  __syncthreads();
  if (tid < 256) {
    int c = tid;
    const float* src = (c < 128) ? (vf + c) : (kf + (c - 128));
    const float* fac = (c < 128) ? s_beta : s_fw;
    int dz;
    asm volatile("v_mov_b32 %0, 0" : "=v"(dz));
    const float* AmV = Am + dz;
    fac += dz;
    float sol[64];
#pragma unroll
    for (int i = 0; i < 64; ++i) {
      float s0 = src[i * 128] * fac[i], s1 = 0.f, s2 = 0.f, s3 = 0.f;
      constexpr int NB = 12;
#pragma unroll
      for (int jb = 0; jb < (i + 3) / 4; jb += NB) {
        float4 a[NB];
#pragma unroll
        for (int j4 = jb; j4 < (i + 3) / 4 && j4 < jb + NB; ++j4) a[j4 - jb] = *(const float4*)&AmV[i * 68 + j4 * 4];
#pragma unroll
        for (int j4 = jb; j4 < (i + 3) / 4 && j4 < jb + NB; ++j4) {
          if (j4 * 4 + 0 < i) s0 -= a[j4 - jb].x * sol[j4 * 4 + 0];
          if (j4 * 4 + 1 < i) s1 -= a[j4 - jb].y * sol[j4 * 4 + 1];
          if (j4 * 4 + 2 < i) s2 -= a[j4 - jb].z * sol[j4 * 4 + 2];
          if (j4 * 4 + 3 < i) s3 -= a[j4 - jb].w * sol[j4 * 4 + 3];
        }
        __builtin_amdgcn_sched_barrier(0);
      }
      sol[i] = (s0 + s1) + (s2 + s3);
      __builtin_amdgcn_sched_barrier(0);
    }
    if (c < 128) {
#pragma unroll
      for (int i8 = 0; i8 < 8; ++i8) *(uint4*)&g_uT[c * 64 + i8 * 8] = pack8(&sol[i8 * 8]);
    } else {
#pragma unroll
      for (int i = 0; i < 64; ++i) g_w[i * 128 + kperm(c - 128)] = f2bf(sol[i]);
    }
  } else {
    int t2 = tid - 256;
    {
      const int dgrp = t2 & 15, seg = dgrp >> 2, e8 = dgrp & 3;
#pragma unroll
      for (int r = 0; r < 4; ++r) {
        const int i = (t2 >> 4) + 16 * r;
        const float f = s_rq[i] * __expf(s_gc[i]);
        float o[8];
        {
          float4 a = *(const float4*)&qf[i * 128 + dgrp * 8], c = *(const float4*)&qf[i * 128 + dgrp * 8 + 4];
          o[0] = a.x * f; o[1] = a.y * f; o[2] = a.z * f; o[3] = a.w * f; o[4] = c.x * f; o[5] = c.y * f; o[6] = c.z * f; o[7] = c.w * f;
        }
        {
          uint4 pk = pack8(o);
          int pb = i * 128 + seg * 32 + ((e8 & 1) * 2) * 8 + (e8 >> 1) * 4;
          *(uint2*)&g_qe[pb] = make_uint2(pk.x, pk.y);
          *(uint2*)&g_qe[pb + 8] = make_uint2(pk.z, pk.w);
        }
      }
    }
    {
      int d = t2 >> 1, ih = t2 & 1;
      float gl = s_gc[63];
#pragma unroll
      for (int e8 = 0; e8 < 4; ++e8) {
        float o[8];
#pragma unroll
        for (int e = 0; e < 8; ++e) {
          int i = ih * 32 + e8 * 8 + e;
          o[e] = kf[i * 128 + d] * s_rk[i] * __expf(gl - s_gc[i]);
        }
        {
          uint4 pk = pack8(o);
          int pb = d * 64 + ih * 32 + ((e8 & 1) * 2) * 8 + (e8 >> 1) * 4;
          *(uint2*)&g_kdT[pb] = make_uint2(pk.x, pk.y);
          *(uint2*)&g_kdT[pb + 8] = make_uint2(pk.z, pk.w);
        }
      }
    }
    if (t2 == 0) ((float*)(ws + WS_GAM))[item] = __expf(s_gc[63]);
  }
  __syncthreads();
}

constexpr int SC_W = 0, SC_QE = 8704, SC_KD = 17408, SC_QK = 26624, SC_O = 31232, SC_BUF = 35840;
template <int MODE>
DEV void gdn_scan(const Params& p, int sid) {
  char* ws = p.ws;
  const u16* P1 = (const u16*)(ws + WS_P1);
  u16* BR = MODE == 0 ? (u16*)(p.out) : (u16*)(ws + WS_STASH);
  const int bh = sid >> 1, sl = sid & 1, h = bh & 3, b = bh >> 2;
  const int tid = threadIdx.x, lane = tid & 63, wid = __builtin_amdgcn_readfirstlane(tid >> 6), fr = lane & 15, fq = lane >> 4;
  u16* bufs = (u16*)smem;
  const u16* gsb = (const u16*)(ws + WS_GS) + (size_t)bh * 128 * GS_ITEM;
  const float* gam = (const float*)(ws + WS_GAM) + bh * 128;
  float* ssq = MODE == 0 ? (float*)(ws + WS_SSQ) : (float*)(ws + WS_STASH + (size_t)110 * 1024 * 1024);
  __syncthreads();
  if (wid >= 4) {
    const int t = tid - 256;
    const unsigned so0 = ((((0*256+t)>>4)*128) + (((0*256+t)&15)*8)), do0 = (SC_W + (((0*256+t)>>4)*136) + (((0*256+t)&15)*8));
    const unsigned so1 = ((((1*256+t)>>4)*128) + (((1*256+t)&15)*8)), do1 = (SC_W + (((1*256+t)>>4)*136) + (((1*256+t)&15)*8));
    const unsigned so2 = ((((2*256+t)>>4)*128) + (((2*256+t)&15)*8)), do2 = (SC_W + (((2*256+t)>>4)*136) + (((2*256+t)&15)*8));
    const unsigned so3 = ((((3*256+t)>>4)*128) + (((3*256+t)&15)*8)), do3 = (SC_W + (((3*256+t)>>4)*136) + (((3*256+t)&15)*8));
    const unsigned so4 = (8192 + (((0*256+t)>>4)*128) + (((0*256+t)&15)*8)), do4 = (SC_QE + (((0*256+t)>>4)*136) + (((0*256+t)&15)*8));
    const unsigned so5 = (8192 + (((1*256+t)>>4)*128) + (((1*256+t)&15)*8)), do5 = (SC_QE + (((1*256+t)>>4)*136) + (((1*256+t)&15)*8));
    const unsigned so6 = (8192 + (((2*256+t)>>4)*128) + (((2*256+t)&15)*8)), do6 = (SC_QE + (((2*256+t)>>4)*136) + (((2*256+t)&15)*8));
    const unsigned so7 = (8192 + (((3*256+t)>>4)*128) + (((3*256+t)&15)*8)), do7 = (SC_QE + (((3*256+t)>>4)*136) + (((3*256+t)&15)*8));
    const unsigned so8 = (16384 + (((0*256+t)>>3)*64) + (((0*256+t)&7)*8)), do8 = (SC_KD + (((0*256+t)>>3)*72) + (((0*256+t)&7)*8));
    const unsigned so9 = (16384 + (((1*256+t)>>3)*64) + (((1*256+t)&7)*8)), do9 = (SC_KD + (((1*256+t)>>3)*72) + (((1*256+t)&7)*8));
    const unsigned so10 = (16384 + (((2*256+t)>>3)*64) + (((2*256+t)&7)*8)), do10 = (SC_KD + (((2*256+t)>>3)*72) + (((2*256+t)&7)*8));
    const unsigned so11 = (16384 + (((3*256+t)>>3)*64) + (((3*256+t)&7)*8)), do11 = (SC_KD + (((3*256+t)>>3)*72) + (((3*256+t)&7)*8));
    const unsigned so12 = (32768 + (((0*256+t)>>3)*64) + (((0*256+t)&7)*8)), do12 = (SC_QK + (((0*256+t)>>3)*72) + (((0*256+t)&7)*8));
    const unsigned so13 = (32768 + (((1*256+t)>>3)*64) + (((1*256+t)&7)*8)), do13 = (SC_QK + (((1*256+t)>>3)*72) + (((1*256+t)&7)*8));
    const int otok = t >> 2, oseg = t & 3;
    const u16* zbase = P1 + ((size_t)b * SEQ + otok) * NP1 + C_ZB + h * 128 + sl * 64 + oseg * 16;
    u16* obase = BR + ((size_t)b * SEQ + otok) * 1536 + 512 + h * 128 + sl * 64 + oseg * 16;
    float* qbase = ssq + (((size_t)b * SEQ + otok) * 4 + h) * 2 + sl;
    float nwv[16];
#pragma unroll
    for (int e = 0; e < 16; ++e) nwv[e] = p.gdn_norm_w[sl * 64 + oseg * 16 + e];
    uint4 sa0, sa1, sa2, sa3, sa4, sa5, sa6, sa7, sa8, sa9, sa10, sa11, sa12, sa13, sa14, sa15;
    uint4 sb_0, sb_1, sb_2, sb_3, sb_4, sb_5, sb_6, sb_7, sb_8, sb_9, sb_10, sb_11, sb_12, sb_13, sb_14, sb_15;
#define GLOADS_A(n_, nz_) do { const u16* gs_ = gsb + (size_t)(n_)*GS_ITEM; const u16* zb_ = zbase + (size_t)((nz_)*64) * NP1; sa0 = *(const uint4*)(gs_ + so0); sa1 = *(const uint4*)(gs_ + so1); sa2 = *(const uint4*)(gs_ + so2); sa3 = *(const uint4*)(gs_ + so3); sa4 = *(const uint4*)(gs_ + so4); sa5 = *(const uint4*)(gs_ + so5); sa6 = *(const uint4*)(gs_ + so6); sa7 = *(const uint4*)(gs_ + so7); sa8 = *(const uint4*)(gs_ + so8); sa9 = *(const uint4*)(gs_ + so9); sa10 = *(const uint4*)(gs_ + so10); sa11 = *(const uint4*)(gs_ + so11); sa12 = *(const uint4*)(gs_ + so12); sa13 = *(const uint4*)(gs_ + so13); sa14 = *(const uint4*)(zb_); sa15 = *(const uint4*)(zb_ + 8); } while (0)
#define GLOADS_B(n_, nz_) do { const u16* gs_ = gsb + (size_t)(n_)*GS_ITEM; const u16* zb_ = zbase + (size_t)((nz_)*64) * NP1; sb_0 = *(const uint4*)(gs_ + so0); sb_1 = *(const uint4*)(gs_ + so1); sb_2 = *(const uint4*)(gs_ + so2); sb_3 = *(const uint4*)(gs_ + so3); sb_4 = *(const uint4*)(gs_ + so4); sb_5 = *(const uint4*)(gs_ + so5); sb_6 = *(const uint4*)(gs_ + so6); sb_7 = *(const uint4*)(gs_ + so7); sb_8 = *(const uint4*)(gs_ + so8); sb_9 = *(const uint4*)(gs_ + so9); sb_10 = *(const uint4*)(gs_ + so10); sb_11 = *(const uint4*)(gs_ + so11); sb_12 = *(const uint4*)(gs_ + so12); sb_13 = *(const uint4*)(gs_ + so13); sb_14 = *(const uint4*)(zb_); sb_15 = *(const uint4*)(zb_ + 8); } while (0)
#define SSTORES_A(buf_) do { u16* bb_ = (buf_); *(uint4*)(bb_ + do0) = sa0; *(uint4*)(bb_ + do1) = sa1; *(uint4*)(bb_ + do2) = sa2; *(uint4*)(bb_ + do3) = sa3; *(uint4*)(bb_ + do4) = sa4; *(uint4*)(bb_ + do5) = sa5; *(uint4*)(bb_ + do6) = sa6; *(uint4*)(bb_ + do7) = sa7; *(uint4*)(bb_ + do8) = sa8; *(uint4*)(bb_ + do9) = sa9; *(uint4*)(bb_ + do10) = sa10; *(uint4*)(bb_ + do11) = sa11; *(uint4*)(bb_ + do12) = sa12; *(uint4*)(bb_ + do13) = sa13; } while (0)
#define SSTORES_B(buf_) do { u16* bb_ = (buf_); *(uint4*)(bb_ + do0) = sb_0; *(uint4*)(bb_ + do1) = sb_1; *(uint4*)(bb_ + do2) = sb_2; *(uint4*)(bb_ + do3) = sb_3; *(uint4*)(bb_ + do4) = sb_4; *(uint4*)(bb_ + do5) = sb_5; *(uint4*)(bb_ + do6) = sb_6; *(uint4*)(bb_ + do7) = sb_7; *(uint4*)(bb_ + do8) = sb_8; *(uint4*)(bb_ + do9) = sb_9; *(uint4*)(bb_ + do10) = sb_10; *(uint4*)(bb_ + do11) = sb_11; *(uint4*)(bb_ + do12) = sb_12; *(uint4*)(bb_ + do13) = sb_13; } while (0)
#define OUTPROC(m_, buf_, z0_, z1_)                                                                         \
  do {                                                                                                     \
    const u16* op_ = (buf_) + SC_O + otok * 72 + oseg * 16;                                                \
    float ov_[16], zv_[16], rv_[16];                                                                       \
    unpack8(*(const uint4*)op_, ov_);                                                                      \
    unpack8(*(const uint4*)(op_ + 8), ov_ + 8);                                                            \
    unpack8(z0_, zv_);                                                                                     \
    unpack8(z1_, zv_ + 8);                                                                                 \
    float q_ = 0.f;                                                                                        \
    _Pragma("unroll") for (int e = 0; e < 16; ++e) { q_ += ov_[e] * ov_[e]; rv_[e] = ov_[e] * nwv[e] * siluf_(zv_[e]); } \
    q_ += __builtin_bit_cast(float, __builtin_amdgcn_update_dpp(0, __builtin_bit_cast(int, q_), 0xB1, 0xf, 0xf, true)); \
    q_ += __builtin_bit_cast(float, __builtin_amdgcn_update_dpp(0, __builtin_bit_cast(int, q_), 0x4E, 0xf, 0xf, true)); \
    u16* od_ = obase + (size_t)((m_)*64) * 1536;                                                           \
    *(uint4*)od_ = pack8(rv_);                                                                             \
    *(uint4*)(od_ + 8) = pack8(rv_ + 8);                                                                   \
    if (oseg == 0) qbase[(size_t)((m_)*64) * 8] = q_;                                                      \
  } while (0)
    GLOADS_A(0, 0);
    SSTORES_A(bufs);
    __builtin_amdgcn_sched_barrier(0);
    GLOADS_B(1, 0);
    __builtin_amdgcn_sched_barrier(0);
    GLOADS_A(2, 0);
    __builtin_amdgcn_sched_barrier(0);
    __syncthreads();
#pragma unroll 1
    for (int n = 0; n < 128; n += 2) {
      if (n > 0) OUTPROC(n - 1, bufs + SC_BUF, sb_14, sb_15);
      SSTORES_B(bufs + SC_BUF);
      GLOADS_B(min(n + 3, 127), n + 1);
      __syncthreads();
      OUTPROC(n, bufs, sa14, sa15);
      SSTORES_A(bufs);
      GLOADS_A(min(n + 4, 127), min(n + 2, 127));
      __syncthreads();
    }
    OUTPROC(127, bufs + SC_BUF, sb_14, sb_15);
#undef GLOADS_A
#undef GLOADS_B
#undef SSTORES_A
#undef SSTORES_B
#undef OUTPROC
  } else {
    const int dvl = wid * 16 + fr;
    const int dv = sl * 64 + dvl;
    f32x4 S[8];
#pragma unroll
    for (int t = 0; t < 8; ++t) S[t] = f32x4{0.f, 0.f, 0.f, 0.f};
    bf16x4 ua[4], ub[4];
    float ga, gb;
#define PFLOAD(ud, gd, n_)                                                                                 \
  do {                                                                                                     \
    const u16* guT = gsb + (size_t)(n_)*GS_ITEM + 24576 + dv * 64 + fq * 4;                                \
    _Pragma("unroll") for (int mt = 0; mt < 4; ++mt) ud[mt] = *(const bf16x4*)(guT + mt * 16);             \
    gd = gam[n_];                                                                                          \
  } while (0)
#define SCAN_STEP(n_, buf_, uu, gamma)                                                                     \
  do {                                                                                                     \
    const u16* buf = (buf_);                                                                               \
    bf16x8 sb[4];                                                                                          \
    _Pragma("unroll") for (int s = 0; s < 4; ++s) sb[s] = pack_acc2(S[2 * s], S[2 * s + 1]);              \
    f32x4 vn[4], oo[4];                                                                                    \
    {                                                                                                      \
      bf16x8 fw[16];                                                                                       \
      _Pragma("unroll") for (int i = 0; i < 16; ++i) fw[i] = *(const bf16x8*)(buf + SC_W + ((i >> 2) * 16 + fr) * 136 + (i & 3) * 32 + fq * 8);  \
      __builtin_amdgcn_sched_barrier(0);                                                                   \
      _Pragma("unroll") for (int mt = 0; mt < 4; ++mt) {                                                   \
        f32x4 a = {0.f, 0.f, 0.f, 0.f};                                                                    \
        _Pragma("unroll") for (int s = 0; s < 4; ++s) a = MFMA16(fw[mt * 4 + s], sb[s], a);                \
        vn[mt] = a;                                                                                        \
      }                                                                                                    \
    }                                                                                                      \
    __builtin_amdgcn_sched_barrier(0);                                                                     \
    bf16x8 vb[2];                                                                                          \
    {                                                                                                      \
      bf16x8 fe[16], fk[8];                                                                                \
      _Pragma("unroll") for (int i = 0; i < 16; ++i) fe[i] = *(const bf16x8*)(buf + SC_QE + ((i >> 2) * 16 + fr) * 136 + (i & 3) * 32 + fq * 8); \
      _Pragma("unroll") for (int i = 0; i < 8; ++i) fk[i] = *(const bf16x8*)(buf + SC_QK + ((i >> 1) * 16 + fr) * 72 + (i & 1) * 32 + fq * 8);   \
      _Pragma("unroll") for (int mt = 0; mt < 4; ++mt)                                                     \
        _Pragma("unroll") for (int jj = 0; jj < 4; ++jj) vn[mt][jj] = bf2f((u16)uu[mt][jj]) - vn[mt][jj];  \
      vb[0] = pack_acc2(vn[0], vn[1]);                                                                     \
      vb[1] = pack_acc2(vn[2], vn[3]);                                                                     \
      __builtin_amdgcn_sched_barrier(0);                                                                   \
      _Pragma("unroll") for (int mt = 0; mt < 4; ++mt) {                                                   \
        f32x4 a = {0.f, 0.f, 0.f, 0.f};                                                                    \
        _Pragma("unroll") for (int s = 0; s < 4; ++s) a = MFMA16(fe[mt * 4 + s], sb[s], a);                \
        _Pragma("unroll") for (int s = 0; s < 2; ++s) a = MFMA16(fk[mt * 2 + s], vb[s], a);                \
        oo[mt] = a;                                                                                        \
      }                                                                                                    \
    }                                                                                                      \
    __builtin_amdgcn_sched_barrier(0);                                                                     \
    {                                                                                                      \
      bf16x8 fd[16];                                                                                       \
      _Pragma("unroll") for (int i = 0; i < 16; ++i) fd[i] = *(const bf16x8*)(buf + SC_KD + ((i >> 1) * 16 + fr) * 72 + (i & 1) * 32 + fq * 8);  \
      __builtin_amdgcn_sched_barrier(0);                                                                   \
      _Pragma("unroll") for (int t = 0; t < 8; ++t) {                                                      \
        f32x4 a = S[t] * gamma;                                                                            \
        _Pragma("unroll") for (int s = 0; s < 2; ++s) a = MFMA16(fd[t * 2 + s], vb[s], a);                 \
        S[t] = a;                                                                                          \
      }                                                                                                    \
    }                                                                                                      \
    {                                                                                                      \
      u16* ow_ = (u16*)buf + SC_O + (fq * 4) * 72 + dvl;                                                   \
      _Pragma("unroll") for (int mt = 0; mt < 4; ++mt)                                                     \
        _Pragma("unroll") for (int jj = 0; jj < 4; ++jj) ow_[(mt * 16 + jj) * 72] = f2bf(oo[mt][jj]);      \
    }                                                                                                      \
  } while (0)
    PFLOAD(ua, ga, 0);
    PFLOAD(ub, gb, 1);
    __syncthreads();
#pragma unroll 1
    for (int n = 0; n < 128; n += 2) {
      if (MODE != 3) SCAN_STEP(n, bufs, ua, ga);
      PFLOAD(ua, ga, min(n + 2, 127));
      __syncthreads();
      if (MODE != 3) SCAN_STEP(n + 1, bufs + SC_BUF, ub, gb);
      PFLOAD(ub, gb, min(n + 3, 127));
      __syncthreads();
    }
#undef PFLOAD
#undef SCAN_STEP
    float* rec = MODE == 0 ? p.out + OFF_RECP + (size_t)bh * 128 * 128 : (float*)(ws + WS_STASH + (size_t)120 * 1024 * 1024) + (size_t)bh * 128 * 128;
#pragma unroll
    for (int t = 0; t < 8; ++t)
#pragma unroll
      for (int jj = 0; jj < 4; ++jj) rec[(t * 16 + fq * 4 + jj) * 128 + dv] = S[t][jj] + (MODE == 3 ? ua[0][0] + ub[0][0] + ga + gb : 0.f);
  }
}

DEV void gdn_finalize(const Params& p) {
  char* ws = p.ws;
  u16* BR = (u16*)(p.out);
  const float* ssq = (const float*)(ws + WS_SSQ);
  int wid = threadIdx.x >> 6, lane = threadIdx.x & 63;
  for (int it = blockIdx.x; it < TP / 8; it += gridDim.x) {
    size_t tok = (size_t)it * 8 + wid;
    int hh = lane >> 4;
    const float2 sp = *(const float2*)(ssq + (tok * 4 + hh) * 2);
    float tot = sp.x + sp.y;
    float rstd = rsqrtf(tot * (1.f / 128.f) + EPS);
    u16* d = BR + tok * 1536 + 512 + lane * 8;
    float v[8];
    unpack8(*(const uint4*)d, v);
#pragma unroll
    for (int e = 0; e < 8; ++e) v[e] *= rstd;
    *(uint4*)d = pack8(v);
  }
}

template <bool SWA>
DEV void attn_item(const Params& p, int item) {
  constexpr int HD = SWA ? 64 : 128;
  constexpr int KST = HD + 8;
  constexpr int VST = 264;
  constexpr int NKS = HD / 32;
  constexpr int NDT = HD / 16;
  constexpr int NKT = SWA ? 9 : 16;
  constexpr int NSL = (NKT + 1) / 2;
  char* ws = p.ws;
  const u16* P1 = (const u16*)(ws + WS_P1);
  u16* BR = (u16*)(p.out);
  const float2* rope = (const float2*)(ws + WS_ROPE);
  u16* Ks = (u16*)smem;
  u16* Vt = Ks + 256 * KST;
  int tid = threadIdx.x, lane = tid & 63, wid = tid >> 6, fr = lane & 15, fq = lane >> 4;
  int b, nb = 0, kvh = 0, h = 0, qblk = 0;
  if (SWA) { kvh = item & 1; nb = (item >> 1) & 63; b = item >> 7; }
  else { qblk = item & 31; h = (item >> 5) & 3; b = item >> 7; }

  __syncthreads();
  if (SWA) {
#pragma unroll
    for (int i = 0; i < 2; ++i) {
      int task = tid + 512 * i, s = task >> 2, dg = task & 3;
      int pos = (nb - 1) * 128 + s;
      float x1[8], x2[8];
      if (pos >= 0) {
        const u16* src = P1 + ((size_t)b * SEQ + pos) * NP1 + C_KA + kvh * 64 + dg * 8;
        unpack8(*(const uint4*)src, x1);
        unpack8(*(const uint4*)(src + 32), x2);
        const float4* rp = (const float4*)(rope + (size_t)pos * 32 + dg * 8);
        float o1[8], o2[8];
#pragma unroll
        for (int e2 = 0; e2 < 4; ++e2) {
          float4 cs = rp[e2];
          o1[2 * e2] = x1[2 * e2] * cs.x - x2[2 * e2] * cs.y;
          o2[2 * e2] = x2[2 * e2] * cs.x + x1[2 * e2] * cs.y;
          o1[2 * e2 + 1] = x1[2 * e2 + 1] * cs.z - x2[2 * e2 + 1] * cs.w;
          o2[2 * e2 + 1] = x2[2 * e2 + 1] * cs.z + x1[2 * e2 + 1] * cs.w;
        }
        *(uint4*)&Ks[s * KST + dg * 8] = pack8(o1);
        *(uint4*)&Ks[s * KST + 32 + dg * 8] = pack8(o2);
        if (nb == 63 && s >= 128) {
          float* o = p.out + OFF_WKP + (((size_t)b * 128 + (s - 128)) * 2 + kvh) * 64 + dg * 8;
          *(float4*)o = make_float4(o1[0], o1[1], o1[2], o1[3]);
          *(float4*)(o + 4) = make_float4(o1[4], o1[5], o1[6], o1[7]);
          *(float4*)(o + 32) = make_float4(o2[0], o2[1], o2[2], o2[3]);
          *(float4*)(o + 36) = make_float4(o2[4], o2[5], o2[6], o2[7]);
        }
      } else {
        uint4 z = make_uint4(0, 0, 0, 0);
        *(uint4*)&Ks[s * KST + dg * 8] = z;
        *(uint4*)&Ks[s * KST + 32 + dg * 8] = z;
      }
    }
#pragma unroll
    for (int i = 0; i < 4; ++i) {
      int task = tid + 512 * i, s = task & 255, dg = task >> 8;
      int pos = (nb - 1) * 128 + s;
      float x[8];
      if (pos >= 0) {
        unpack8(*(const uint4*)(P1 + ((size_t)b * SEQ + pos) * NP1 + C_VA + kvh * 64 + dg * 8), x);
        if (nb == 63 && s >= 128) {
          float* o = p.out + OFF_WVP + (((size_t)b * 128 + (s - 128)) * 2 + kvh) * 64 + dg * 8;
          *(float4*)o = make_float4(x[0], x[1], x[2], x[3]);
          *(float4*)(o + 4) = make_float4(x[4], x[5], x[6], x[7]);
        }
      } else {
#pragma unroll
        for (int e = 0; e < 8; ++e) x[e] = 0.f;
      }
#pragma unroll
      for (int e = 0; e < 8; ++e) Vt[(dg * 8 + e) * VST + s] = f2bf(x[e]);
    }
  } else {
    const u16* MK = (const u16*)(ws + WS_MEMKV);
#pragma unroll
    for (int i = 0; i < 8; ++i) {
      int task = tid + 512 * i, s = task >> 4, dg = task & 15;
      *(uint4*)&Ks[s * KST + dg * 8] = *(const uint4*)(MK + ((size_t)b * 256 + s) * 1024 + h * 128 + dg * 8);
    }
#pragma unroll
    for (int i = 0; i < 8; ++i) {
      int task = tid + 512 * i, s = task & 255, dg = task >> 8;
      uint4 v = *(const uint4*)(MK + ((size_t)b * 256 + s) * 1024 + 512 + h * 128 + dg * 8);
      const u16* ve = (const u16*)&v;
#pragma unroll
      for (int e = 0; e < 8; ++e) Vt[(dg * 8 + e) * VST + s] = ve[e];
    }
  }
  __syncthreads();

  const float LOG2E = 1.4426950408889634f;
  const float sl = (SWA ? 0.125f : 0.08838834764831845f) * LOG2E;
#pragma unroll 1
  for (int qi = 0; qi < (SWA ? 4 : 2); ++qi) {
    int qrow, kt0, head = 0;
    size_t tok;
    if (SWA) {
      int qt = (wid & 1) * 4 + qi;
      head = kvh * 4 + (wid >> 1);
      qrow = qt * 16 + fr;
      tok = (size_t)b * SEQ + nb * 128 + qrow;
      kt0 = qt;
    } else {
      qrow = wid * 32 + qi * 16 + fr;
      tok = (size_t)b * SEQ + qblk * 256 + qrow;
      kt0 = 0;
    }
    bf16x8 qf[NKS];
    if (SWA) {
      const u16* src = P1 + tok * NP1 + C_QA + head * 64 + fq * 8;
      float x1[8], x2[8], o1[8], o2[8];
      unpack8(*(const uint4*)src, x1);
      unpack8(*(const uint4*)(src + 32), x2);
      const float4* rp = (const float4*)(rope + (size_t)(nb * 128 + qrow) * 32 + fq * 8);
#pragma unroll
      for (int e2 = 0; e2 < 4; ++e2) {
        float4 cs = rp[e2];
        o1[2 * e2] = x1[2 * e2] * cs.x - x2[2 * e2] * cs.y;
        o2[2 * e2] = x2[2 * e2] * cs.x + x1[2 * e2] * cs.y;
        o1[2 * e2 + 1] = x1[2 * e2 + 1] * cs.z - x2[2 * e2 + 1] * cs.w;
        o2[2 * e2 + 1] = x2[2 * e2 + 1] * cs.z + x1[2 * e2 + 1] * cs.w;
      }
      union { uint4 u; bf16x8 v; } c1, c2;
      c1.u = pack8(o1); c2.u = pack8(o2);
      qf[0] = c1.v; qf[NKS - 1] = c2.v;
    } else {
      const u16* src = P1 + tok * NP1 + C_QC + h * 128 + fq * 8;
#pragma unroll
      for (int ks = 0; ks < NKS; ++ks) qf[ks] = *(const bf16x8*)(src + ks * 32);
    }
    f32x4 st[NKT];
#pragma unroll
    for (int j = 0; j < NKT; ++j) {
      f32x4 a = {0.f, 0.f, 0.f, 0.f};
#pragma unroll
      for (int ks = 0; ks < NKS; ++ks) {
        bf16x8 kfr = *(const bf16x8*)&Ks[((kt0 + j) * 16 + fr) * KST + ks * 32 + fq * 8];
        a = MFMA16(kfr, qf[ks], a);
      }
      st[j] = a;
      if ((j & 1) == 1) __builtin_amdgcn_sched_barrier(0);
    }
    float m2 = -INFINITY;
#pragma unroll
    for (int j = 0; j < NKT; ++j) {
#pragma unroll
      for (int jj = 0; jj < 4; ++jj) {
        float v = st[j][jj] * sl;
        if (SWA) {
          int sidx = (kt0 + j) * 16 + fq * 4 + jj;
          bool ok = (sidx > qrow) && (sidx <= qrow + 128) && (nb > 0 || sidx >= 128);
          v = ok ? v : -INFINITY;
        }
        st[j][jj] = v;
        m2 = fmaxf(m2, v);
      }
    }
    m2 = fmaxf(m2, __shfl_xor(m2, 16));
    m2 = fmaxf(m2, __shfl_xor(m2, 32));
    float sink2 = 0.f;
    if (SWA) { sink2 = p.attn_sink[head] * LOG2E; m2 = fmaxf(m2, sink2); }
    float l = 0.f;
#pragma unroll
    for (int j = 0; j < NKT; ++j) {
#pragma unroll
      for (int jj = 0; jj < 4; ++jj) {
        float pv = __builtin_amdgcn_exp2f(st[j][jj] - m2);
        st[j][jj] = pv;
        l += pv;
      }
    }
    l += __shfl_xor(l, 16);
    l += __shfl_xor(l, 32);
    if (SWA) l += __builtin_amdgcn_exp2f(sink2 - m2);
    float inv = 1.f / l;
    f32x4 ot[NDT];
#pragma unroll
    for (int dt = 0; dt < NDT; ++dt) ot[dt] = f32x4{0.f, 0.f, 0.f, 0.f};
#pragma unroll
    for (int s = 0; s < NSL; ++s) {
      bf16x8 pb;
      int t0 = kt0 + 2 * s, t1;
      if (2 * s + 1 < NKT) { pb = pack_acc2(st[2 * s], st[2 * s + 1]); t1 = t0 + 1; }
      else { f32x4 z = {0.f, 0.f, 0.f, 0.f}; pb = pack_acc2(st[2 * s], z); t1 = t0; }
#pragma unroll
      for (int dt = 0; dt < NDT; ++dt) {
        const u16* vp = Vt + (dt * 16 + fr) * VST + fq * 4;
        ot[dt] = MFMA16(mk8(*(const bf16x4*)(vp + t0 * 16), *(const bf16x4*)(vp + t1 * 16)), pb, ot[dt]);
      }
      __builtin_amdgcn_sched_barrier(0);
    }
    u16* dst = BR + tok * 1536 + (SWA ? head * 64 : 1024 + h * 128) + fq * 4;
#pragma unroll
    for (int dt = 0; dt < NDT; ++dt) store_bf4(dst + dt * 16, ot[dt] * inv);
  }
  __syncthreads();
}

DEV void swa_decode_item(const Params& p, int b) {
  char* ws = p.ws;
  const u16* P1 = (const u16*)(ws + WS_P1);
  u16* BR = (u16*)(p.out);
  const float2* rope = (const float2*)(ws + WS_ROPE);
  float* Kw = (float*)smem;
  float* Vw = Kw + 132 * 128;
  float* Qs = Vw + 132 * 128;
  float* Ps = Qs + 32 * 64;
  int tid = threadIdx.x;
  __syncthreads();
  for (int i = tid; i < 128 * 32; i += 512) {
    ((float4*)Kw)[i] = ((const float4*)(p.state_win_k + (size_t)b * 16384))[i];
    ((float4*)Vw)[i] = ((const float4*)(p.state_win_v + (size_t)b * 16384))[i];
  }
  if (tid < 256) {
    int t = tid >> 6, c = tid & 63, kvh = c >> 5, d = c & 31;
    size_t tok = (size_t)TP + b * 4 + t;
    const u16* src = P1 + tok * NP1;
    float2 cs = rope[(size_t)(8192 + t) * 32 + d];
    float x1 = bf2f(src[C_KA + kvh * 64 + d]), x2 = bf2f(src[C_KA + kvh * 64 + 32 + d]);
    Kw[(128 + t) * 128 + kvh * 64 + d] = x1 * cs.x - x2 * cs.y;
    Kw[(128 + t) * 128 + kvh * 64 + 32 + d] = x2 * cs.x + x1 * cs.y;
    Vw[(128 + t) * 128 + c] = bf2f(src[C_VA + c]);
    Vw[(128 + t) * 128 + 64 + c] = bf2f(src[C_VA + 64 + c]);
  }
  for (int i = tid; i < 4 * 8 * 32; i += 512) {
    int t = i >> 8, hh = (i >> 5) & 7, d = i & 31;
    size_t tok = (size_t)TP + b * 4 + t;
    const u16* src = P1 + tok * NP1 + C_QA + hh * 64;
    float2 cs = rope[(size_t)(8192 + t) * 32 + d];
    float x1 = bf2f(src[d]), x2 = bf2f(src[32 + d]);
    Qs[(t * 8 + hh) * 64 + d] = x1 * cs.x - x2 * cs.y;
    Qs[(t * 8 + hh) * 64 + 32 + d] = x2 * cs.x + x1 * cs.y;
  }
  __syncthreads();
  for (int i = tid; i < 128 * 32; i += 512) {
    ((float4*)(p.out + OFF_WKS + (size_t)b * 16384))[i] = ((const float4*)(Kw + 4 * 128))[i];
    ((float4*)(p.out + OFF_WVS + (size_t)b * 16384))[i] = ((const float4*)(Vw + 4 * 128))[i];
  }
  int pr = tid >> 4, sub = tid & 15, t = pr >> 3, hh = pr & 7, kvh = hh >> 2;
  const float* q = Qs + pr * 64;
  float lg[9];
  float m = -INFINITY;
#pragma unroll
  for (int r = 0; r < 9; ++r) {
    int s = sub + 16 * r;
    float v = -INFINITY;
    if (s < 132) {
      bool ok = s < 128 ? (s > t) : ((s - 128) <= t);
      if (ok) {
        const float* kp = Kw + s * 128 + kvh * 64;
        float a = 0.f;
#pragma unroll 16
        for (int d = 0; d < 64; ++d) { int dd = (d + sub * 4) & 63; a += q[dd] * kp[dd]; }
        v = a * 0.125f;
      }
    }
    lg[r] = v;
    m = fmaxf(m, v);
  }
#pragma unroll
  for (int o = 1; o < 16; o <<= 1) m = fmaxf(m, __shfl_xor(m, o));
  float sink = p.attn_sink[hh];
  m = fmaxf(m, sink);
  float l = 0.f;
#pragma unroll
  for (int r = 0; r < 9; ++r) {
    int s = sub + 16 * r;
    float pv = __expf(lg[r] - m);
    if (s < 132) Ps[pr * 132 + s] = pv;
    l += pv;
  }
#pragma unroll
  for (int o = 1; o < 16; o <<= 1) l += __shfl_xor(l, o);
  l += __expf(sink - m);
  float inv = 1.f / l;
  __syncthreads();
  float o4[4] = {0, 0, 0, 0};
  for (int s = 0; s < 132; ++s) {
    float pv = Ps[pr * 132 + s];
    float4 v = *(const float4*)(Vw + s * 128 + kvh * 64 + sub * 4);
    o4[0] += pv * v.x; o4[1] += pv * v.y; o4[2] += pv * v.z; o4[3] += pv * v.w;
  }
  size_t tok = (size_t)TP + b * 4 + t;
  uint2 w; w.x = pack2(o4[0] * inv, o4[1] * inv); w.y = pack2(o4[2] * inv, o4[3] * inv);
  *(uint2*)(BR + tok * 1536 + hh * 64 + sub * 4) = w;
  __syncthreads();
}

DEV void mem_decode_item(const Params& p, int item) {
  char* ws = p.ws;
  const u16* P1 = (const u16*)(ws + WS_P1);
  u16* BR = (u16*)(p.out);
  int h = item & 3, b = item >> 2;
  float* qs = (float*)smem;
  float* lgs = qs + 512;
  float* red = lgs + 1024;
  float* linv = red + 2048;
  int tid = threadIdx.x, lane = tid & 63, wid = tid >> 6;
  __syncthreads();
  {
    int t = tid >> 7, d = tid & 127;
    qs[tid] = bf2f(P1[((size_t)TP + b * 4 + t) * NP1 + C_QC + h * 128 + d]);
  }
  __syncthreads();
  {
    int key = tid >> 1, hf = tid & 1;
    const float4* kp = (const float4*)(p.cache_mem_k + (((size_t)b * 256 + key) * 4 + h) * 128 + hf * 64);
    float a[4] = {0, 0, 0, 0};
#pragma unroll
    for (int i = 0; i < 16; ++i) {
      float4 kv = kp[i];
#pragma unroll
      for (int t = 0; t < 4; ++t) {
        float4 qv = *(const float4*)(qs + t * 128 + hf * 64 + i * 4);
        a[t] += kv.x * qv.x + kv.y * qv.y + kv.z * qv.z + kv.w * qv.w;
      }
    }
#pragma unroll
    for (int t = 0; t < 4; ++t) a[t] += __shfl_xor(a[t], 1);
    if (hf == 0) {
#pragma unroll
      for (int t = 0; t < 4; ++t) lgs[t * 256 + key] = a[t] * 0.08838834764831845f;
    }
  }
  __syncthreads();
  if (wid < 4) {
    float v[4], m = -INFINITY;
#pragma unroll
    for (int i = 0; i < 4; ++i) { v[i] = lgs[wid * 256 + lane + 64 * i]; m = fmaxf(m, v[i]); }
#pragma unroll
    for (int o = 32; o > 0; o >>= 1) m = fmaxf(m, __shfl_xor(m, o));
    float l = 0.f;
#pragma unroll
    for (int i = 0; i < 4; ++i) { v[i] = __expf(v[i] - m); l += v[i]; lgs[wid * 256 + lane + 64 * i] = v[i]; }
    l = wave_sum(l);
    if (lane == 0) linv[wid] = 1.f / l;
  }
  __syncthreads();
  {
    int d = tid & 127, kq = tid >> 7;
    float a[4] = {0, 0, 0, 0};
    const float* vp = p.cache_mem_v + (((size_t)b * 256 + kq * 64) * 4 + h) * 128 + d;
#pragma unroll 8
    for (int s = 0; s < 64; ++s) {
      float v = vp[(size_t)s * 512];
#pragma unroll
      for (int t = 0; t < 4; ++t) a[t] += lgs[t * 256 + kq * 64 + s] * v;
    }
#pragma unroll
    for (int t = 0; t < 4; ++t) red[(kq * 4 + t) * 128 + d] = a[t];
  }
  __syncthreads();
  {
    int t = tid >> 7, d = tid & 127;
    float o = (red[(0 * 4 + t) * 128 + d] + red[(1 * 4 + t) * 128 + d] + red[(2 * 4 + t) * 128 + d] + red[(3 * 4 + t) * 128 + d]) * linv[t];
    BR[((size_t)TP + b * 4 + t) * 1536 + 1024 + h * 128 + d] = f2bf(o);
  }
  __syncthreads();
}

DEV void gdn_decode_item(const Params& p, int item) {
  char* ws = p.ws;
  const u16* P1 = (const u16*)(ws + WS_P1);
  u16* BR = (u16*)(p.out);
  int h = item & 3, b = item >> 2;
  int tid = threadIdx.x, lane = tid & 63, wid = tid >> 6;
  float* qkv = (float*)smem;
  float* red = qkv + 1536;
  float* os = red + 512;
  float* sg = os + 512;
  float* rn = sg + 8;
  __syncthreads();
  if (tid < 384) {
    int part = tid >> 7, d = tid & 127, ch = part * 512 + h * 128 + d;
    float xr[7];
#pragma unroll
    for (int r = 0; r < 3; ++r) xr[r] = p.state_conv[((size_t)b * 3 + r) * 1536 + ch];
#pragma unroll
    for (int t = 0; t < 4; ++t) xr[3 + t] = bf2f(P1[((size_t)TP + b * 4 + t) * NP1 + C_QKVB + ch]);
    float cw[4];
#pragma unroll
    for (int j = 0; j < 4; ++j) cw[j] = p.gdn_conv_w[j * 1536 + ch];
#pragma unroll
    for (int t = 0; t < 4; ++t) {
      float s = xr[t] * cw[0] + xr[t + 1] * cw[1] + xr[t + 2] * cw[2] + xr[t + 3] * cw[3];
      qkv[(t * 3 + part) * 128 + d] = siluf_(s);
    }
#pragma unroll
    for (int r = 0; r < 3; ++r) p.out[OFF_CVS + ((size_t)b * 3 + r) * 1536 + ch] = xr[4 + r];
  } else if (tid < 388) {
    int t = tid - 384;
    const float* ba = (const float*)(ws + WS_BA) + ((size_t)TP + b * 4 + t) * 8;
    sg[4 + t] = sigmoidf_(ba[h]);
    sg[t] = -__expf(p.gdn_a_log[h]) * softplusf_(ba[4 + h] + p.gdn_dt_bias[h]);
  }
  __syncthreads();
  {
    int t = wid >> 1, which = wid & 1;
    float* v = qkv + (t * 3 + which) * 128;
    float a = v[lane], c = v[lane + 64];
    float ss = wave_sum(a * a + c * c);
    float rs = rsqrtf(ss + EPS) * (which ? 1.f : 0.08838834764831845f);
    v[lane] = a * rs; v[lane + 64] = c * rs;
  }
  int dv = tid & 127, dkq = tid >> 7;
  float S[32];
  const float* sp = p.state_rec + ((size_t)item * 128 + dkq * 32) * 128 + dv;
#pragma unroll
  for (int r = 0; r < 32; ++r) S[r] = sp[r * 128];
  __syncthreads();
#pragma unroll 1
  for (int t = 0; t < 4; ++t) {
    const float* qv = qkv + (t * 3 + 0) * 128 + dkq * 32;
    const float* kv = qkv + (t * 3 + 1) * 128 + dkq * 32;
    float vv = qkv[(t * 3 + 2) * 128 + dv];
    float a = __expf(sg[t]), beta = sg[4 + t];
    float part = 0.f;
#pragma unroll
    for (int r = 0; r < 32; ++r) part += S[r] * kv[r];
    red[dkq * 128 + dv] = part;
    __syncthreads();
    float sk = red[dv] + red[128 + dv] + red[256 + dv] + red[384 + dv];
    float vnew = beta * (vv - a * sk);
    __syncthreads();
    float po = 0.f;
#pragma unroll
    for (int r = 0; r < 32; ++r) { S[r] = a * S[r] + kv[r] * vnew; po += S[r] * qv[r]; }
    red[dkq * 128 + dv] = po;
    __syncthreads();
    if (dkq == 0) os[t * 128 + dv] = red[dv] + red[128 + dv] + red[256 + dv] + red[384 + dv];
    __syncthreads();
  }
  float* rp = p.out + OFF_RECS + ((size_t)item * 128 + dkq * 32) * 128 + dv;
#pragma unroll
  for (int r = 0; r < 32; ++r) rp[r * 128] = S[r];
  if (wid < 4) {
    float a = os[wid * 128 + lane], c = os[wid * 128 + lane + 64];
    float ss = wave_sum(a * a + c * c);
    if (lane == 0) rn[wid] = rsqrtf(ss * (1.f / 128.f) + EPS);
  }
  __syncthreads();
  {
    int t = tid >> 7, d = tid & 127;
    size_t tok = (size_t)TP + b * 4 + t;
    float z = bf2f(P1[tok * NP1 + C_ZB + h * 128 + d]);
    float o = os[t * 128 + d] * rn[t] * p.gdn_norm_w[d] * siluf_(z);
    BR[tok * 1536 + 512 + h * 128 + d] = f2bf(o);
  }
  __syncthreads();
}

DEV void rowpass1(const Params& p) {
  char* ws = p.ws;
  int wid = threadIdx.x >> 6, lane = threadIdx.x & 63;
  for (int it = blockIdx.x; it < TT / 8; it += gridDim.x) {
    int r = it * 8 + wid;
    const float* xs = r < TP ? p.x_prompt + (size_t)r * DM : p.x_sample + (size_t)(r - TP) * DM;
    const u16* mx = (const u16*)(ws + WS_MIX) + (size_t)r * DM;
    float mv[4][4];
    float ss = 0.f;
#pragma unroll
    for (int i = 0; i < 4; ++i) {
      if (r < TP) {
        uint2 w = ((const uint2*)mx)[lane + 64 * i];
        mv[i][0] = bflo(w.x); mv[i][1] = bfhi(w.x); mv[i][2] = bflo(w.y); mv[i][3] = bfhi(w.y);
      } else {
        float4 w = make_float4(0.f, 0.f, 0.f, 0.f);
#pragma unroll
        for (int ks = 0; ks < 4; ++ks) {
          float4 q = ((const float4*)((const float*)(ws + WS_ACC6) + ((size_t)ks * TSMP + (r - TP)) * DM))[lane + 64 * i];
          w.x += q.x; w.y += q.y; w.z += q.z; w.w += q.w;
        }
        mv[i][0] = w.x; mv[i][1] = w.y; mv[i][2] = w.z; mv[i][3] = w.w;
      }
      ss += mv[i][0] * mv[i][0] + mv[i][1] * mv[i][1] + mv[i][2] * mv[i][2] + mv[i][3] * mv[i][3];
    }
    ss = wave_sum(ss);
    float rstd = rsqrtf(ss * (1.f / DM) + EPS);
    float x1[4][4];
    float s2 = 0.f;
#pragma unroll
    for (int i = 0; i < 4; ++i) {
      float4 xv = ((const float4*)xs)[lane + 64 * i];
      float4 g = ((const float4*)p.ln_mix_post)[lane + 64 * i];
      x1[i][0] = xv.x + mv[i][0] * rstd * g.x; x1[i][1] = xv.y + mv[i][1] * rstd * g.y;
      x1[i][2] = xv.z + mv[i][2] * rstd * g.z; x1[i][3] = xv.w + mv[i][3] * rstd * g.w;
      s2 += x1[i][0] * x1[i][0] + x1[i][1] * x1[i][1] + x1[i][2] * x1[i][2] + x1[i][3] * x1[i][3];
      ((float4*)(p.out + (size_t)r * DM))[lane + 64 * i] = make_float4(x1[i][0], x1[i][1], x1[i][2], x1[i][3]);
    }
    s2 = wave_sum(s2);
    float r2 = rsqrtf(s2 * (1.f / DM) + EPS);
    u16* hd = (u16*)(ws + WS_H) + (size_t)r * DM;
#pragma unroll
    for (int i = 0; i < 4; ++i) {
      float4 g = ((const float4*)p.ln_ffn_pre)[lane + 64 * i];
      uint2 w; w.x = pack2(x1[i][0] * r2 * g.x, x1[i][1] * r2 * g.y); w.y = pack2(x1[i][2] * r2 * g.z, x1[i][3] * r2 * g.w);
      ((uint2*)hd)[lane + 64 * i] = w;
    }
  }
}
DEV void rowpass2(const Params& p) {
  char* ws = p.ws;
  int wid = threadIdx.x >> 6, lane = threadIdx.x & 63;
  for (int it = blockIdx.x; it < TT / 8; it += gridDim.x) {
    int r = it * 8 + wid;
    const u16* fx = (const u16*)(ws + WS_F2) + (size_t)r * DM;
    float mv[4][4];
    float ss = 0.f;
#pragma unroll
    for (int i = 0; i < 4; ++i) {
      if (r < TP) {
        uint2 w = ((const uint2*)fx)[lane + 64 * i];
        mv[i][0] = bflo(w.x); mv[i][1] = bfhi(w.x); mv[i][2] = bflo(w.y); mv[i][3] = bfhi(w.y);
      } else {
        float4 w = make_float4(0.f, 0.f, 0.f, 0.f);
#pragma unroll
        for (int ks = 0; ks < 11; ++ks) {
          float4 q = ((const float4*)((const float*)(ws + WS_ACC9) + ((size_t)ks * TSMP + (r - TP)) * DM))[lane + 64 * i];
          w.x += q.x; w.y += q.y; w.z += q.z; w.w += q.w;
        }
        mv[i][0] = w.x; mv[i][1] = w.y; mv[i][2] = w.z; mv[i][3] = w.w;
      }
      ss += mv[i][0] * mv[i][0] + mv[i][1] * mv[i][1] + mv[i][2] * mv[i][2] + mv[i][3] * mv[i][3];
    }
    ss = wave_sum(ss);
    float rstd = rsqrtf(ss * (1.f / DM) + EPS);
    float4* yo = (float4*)(p.out + (size_t)r * DM);
#pragma unroll
    for (int i = 0; i < 4; ++i) {
      float4 xv = yo[lane + 64 * i];
      float4 g = ((const float4*)p.ln_ffn_post)[lane + 64 * i];
      xv.x += mv[i][0] * rstd * g.x; xv.y += mv[i][1] * rstd * g.y; xv.z += mv[i][2] * rstd * g.z; xv.w += mv[i][3] * rstd * g.w;
      yo[lane + 64 * i] = xv;
    }
  }
}

DEV u16* gate_ptr(char* ws, int row, int c) {
  if (row >= TP) return (u16*)(ws + WS_GSMP) + (size_t)(row - TP) * NGATE + c;
  u16* base = (u16*)(ws + WS_P1) + (size_t)row * NP1;
  return base + (c < 1536 ? 768 + c : (c < 2304 ? c - 1536 : c));
}
DEV void gate_tile(const Params& p, int pm, int pn, bool pre, GNext nx) {
  char* ws = p.ws;
  gemm_tile((const u16*)(ws + WS_H), 1024, (const u16*)(ws + WS_WIN) + (size_t)NP1 * 1024, 1024, 1024, pm * 256, pn * 256, pre, nx,
            [&](AccRef acc, int r0, int c0) {
              EPI_LOOP(ai, bj, m, n) {
                int row = r0 + ai * 128 + m * 16, col = c0 + bj * 128 + n * 4;
                f32x4 v = acc[ai][bj][m][n];
                f32x4 sg = {sigmoidf_(v[0]), sigmoidf_(v[1]), sigmoidf_(v[2]), sigmoidf_(v[3])};
                store_bf4(gate_ptr(ws, row, col), sg);
              }
            });
}

DEV void gate_item(const Params& p, int it) {
  int pm, pn;
  if (it < 768) tile_map(it, 128, 6, pm, pn);
  else { int s2 = it - 768; pm = 128 + s2 / 12; pn = s2 % 12; }
  GNext nx;
  nx.A = nullptr; nx.B = nullptr; nx.brow = 0; nx.bcol = 0; nx.valid = 0;
  gate_tile(p, pm, pn, false, nx);
}

constexpr int NSCAN = 32;
__global__ void __launch_bounds__(512) fwd_megakernel(Params p) {
  char* ws = p.ws;
  const int G = gridDim.x, bid = blockIdx.x;
  const int lo = (int)p.ph_lo, hi = (int)p.ph_hi;
#ifndef ONLY_PH
#define ONLY_PH -1
#endif
#ifndef REP_MASK
#define REP_MASK 0
#endif
#define PH(k) if ((ONLY_PH < 0 || ONLY_PH == (k)) && lo <= (k) && (k) < hi) for (int rep_ = 0; rep_ <= (((REP_MASK) >> (k)) & 1); ++rep_)
#define SYNC(k) if (lo <= (k) && (k) + 1 < hi) { cg::this_grid().sync(); }
  PH(0) phase_prep(p);
  SYNC(0)
  PH(1) gemm_p1_phase(p);
  SYNC(1)
  PH(2) for (int it = bid; it < 2048; it += G) gdn_pre_item(p, it);
  SYNC(2)
  PH(3) {
#ifndef ONLY_SUB
#define ONLY_SUB -1
#endif
#ifndef SUB_MASK
#define SUB_MASK 63
#endif
#define SUB(k) (((SUB_MASK) >> (k)) & 1)
#ifndef REP_SUB
#define REP_SUB 0
#endif
#ifndef REP_SCAN
#define REP_SCAN 0
#endif
    if (bid < NSCAN) gdn_scan<0>(p, bid);
    {
      unsigned* ctr = (unsigned*)(ws + WS_CTR);
      volatile int* slot = (volatile int*)(smem + LDS_BYTES - 16);
#define QUEUE_LOOP(k_, n_, body_)                                        \
  for (;;) {                                                             \
    __syncthreads();                                                     \
    if (threadIdx.x == 0) *slot = (int)atomicAdd(ctr + (k_), 1u);        \
    __syncthreads();                                                     \
    const int it = *slot;                                                \
    if (it >= (n_)) break;                                               \
    body_;                                                               \
  }
      QUEUE_LOOP(0, 792, gate_item(p, it))
      QUEUE_LOOP(1, 512, attn_item<true>(p, it))
      QUEUE_LOOP(2, 512, attn_item<false>(p, it))
      QUEUE_LOOP(3, 128, swa_decode_item(p, it))
      QUEUE_LOOP(4, 512, mem_decode_item(p, it))
      QUEUE_LOOP(5, 512, gdn_decode_item(p, it))
#undef QUEUE_LOOP
    }
  }
  SYNC(3)
#ifdef PROBE_SCAN_MODE
  PH(3) { if (bid < NSCAN) gdn_scan<PROBE_SCAN_MODE>(p, bid); }
  SYNC(3)
#endif
  PH(4) {
    gdn_finalize(p);
    bool pre = false;
    for (int t = bid; t < 768; t += G) {
      int pm, pn; tile_map(t, 128, 6, pm, pn);
      GNext nx{(const u16*)(ws + WS_H), (const u16*)(ws + WS_WIN) + (size_t)NP1 * 1024, 0, 0, 0};
      if (t + G < 768) { int qm, qn; tile_map(t + G, 128, 6, qm, qn); nx.brow = qm * 256; nx.bcol = (qn + 6) * 256; nx.valid = 1; }
      const bool pre_now = pre; pre = nx.valid;
      gate_tile(p, pm, pn + 6, pre_now, nx);
    }
  }
  SYNC(4)
  PH(5) {
    u16* stash = (u16*)(ws + WS_STASH);
    const u16* BR = (const u16*)p.out;
    bool pre = false;
    for (int t = bid; t < 520; t += G) {
      int pm, pn; tile_map(t, 130, 4, pm, pn);
#pragma unroll 1
      for (int nbr = 0; nbr < 3; ++nbr) {
        GNext nx{nullptr, nullptr, pm * 256, pn * 256, 0};
        if (nbr < 2) { nx.A = BR + (nbr + 1) * 512; nx.B = (const u16*)(ws + WS_WBR) + (size_t)(nbr + 1) * 1024 * 512; nx.valid = 1; }
        else if (t + G < 520) { int qm, qn; tile_map(t + G, 130, 4, qm, qn); nx.A = BR; nx.B = (const u16*)(ws + WS_WBR); nx.brow = qm * 256; nx.bcol = qn * 256; nx.valid = 1; }
        const bool pre_now = pre; pre = nx.valid;
        gemm_tile(BR + nbr * 512, 1536, (const u16*)(ws + WS_WBR) + (size_t)nbr * 1024 * 512, 512, 512, pm * 256, pn * 256, pre_now, nx,
                  [&](AccRef acc, int r0, int c0) {
                    EPI_LOOP(ai, bj, m, n) {
                      int row = r0 + ai * 128 + m * 16, col = c0 + bj * 128 + n * 4;
                      f32x4 v = acc[ai][bj][m][n];
                      uint2 gw = *(const uint2*)gate_ptr(ws, row, nbr * 1024 + col);
                      f32x4 r = {v[0] * bflo(gw.x), v[1] * bfhi(gw.x), v[2] * bflo(gw.y), v[3] * bfhi(gw.y)};
                      u16* sp = stash + (size_t)row * DM + col;
                      if (nbr > 0) {
                        uint2 sw = *(const uint2*)sp;
                        r[0] += bflo(sw.x); r[1] += bfhi(sw.x); r[2] += bflo(sw.y); r[3] += bfhi(sw.y);
                      }
                      store_bf4(sp, r);
                    }
                  });
      }
    }
  }
  SYNC(5)
  PH(6) {
    u16* mix = (u16*)(ws + WS_MIX);
    float* acc6 = (float*)(ws + WS_ACC6);
    bool pre = false;
    for (int t = bid; t < 544; t += G) {
      if (t < 512) {
        int pm, pn; tile_map(t, 128, 4, pm, pn);
        GNext nx{(const u16*)(ws + WS_STASH), (const u16*)(ws + WS_WOUT), 0, 0, 0};
        if (t + G < 512) { int qm, qn; tile_map(t + G, 128, 4, qm, qn); nx.brow = qm * 256; nx.bcol = qn * 256; nx.valid = 1; }
        const bool pre_now = pre; pre = nx.valid;
        gemm_tile((const u16*)(ws + WS_STASH), 1024, (const u16*)(ws + WS_WOUT), 1024, 1024, pm * 256, pn * 256, pre_now, nx,
                  [&](AccRef acc, int r0, int c0) {
                    EPI_LOOP(ai, bj, m, n) {
                      int row = r0 + ai * 128 + m * 16, col = c0 + bj * 128 + n * 4;
                      store_bf4(mix + (size_t)row * DM + col, acc[ai][bj][m][n]);
                    }
                  });
      } else {
        const int s2 = t - 512, tl = s2 >> 2, ks = s2 & 3, pm = 128 + (tl >> 2), pn = tl & 3;
        gemm_tile((const u16*)(ws + WS_STASH) + ks * 256, 1024, (const u16*)(ws + WS_WOUT) + ks * 256, 1024, 256, pm * 256, pn * 256, false,
                  GNext{nullptr, nullptr, 0, 0, 0},
                  [&](AccRef acc, int r0, int c0) {
                    EPI_LOOP(ai, bj, m, n) {
                      int row = r0 + ai * 128 + m * 16 - TP, col = c0 + bj * 128 + n * 4;
                      float* d = acc6 + ((size_t)ks * TSMP + row) * DM + col;
                      f32x4 v = acc[ai][bj][m][n];
                      *(float4*)d = make_float4(v[0], v[1], v[2], v[3]);
                    }
                  });
        pre = false;
      }
    }
  }
  SYNC(6)
  PH(7) rowpass1(p);
  SYNC(7)
  PH(8) {
    u16* F1 = (u16*)(ws + WS_P1);
    bool pre = false;
    for (int t = bid; t < 2860; t += G) {
      int pm, pn; tile_map(t, 130, 22, pm, pn);
      GNext nx{(const u16*)(ws + WS_H), (const u16*)(ws + WS_WF1), 0, 0, 0};
      if (t + G < 2860) { int qm, qn; tile_map(t + G, 130, 22, qm, qn); nx.brow = qm * 256; nx.bcol = qn * 256; nx.valid = 1; }
      const bool pre_now = pre; pre = nx.valid;
      gemm_tile((const u16*)(ws + WS_H), 1024, (const u16*)(ws + WS_WF1), 1024, 1024, pm * 256, pn * 256, pre_now, nx,
                [&](AccRef acc, int r0, int c0) {
                  int cbase = pn * 128 + (c0 - pn * 256);
                  _Pragma("unroll") for (int ai = 0; ai < 2; ++ai) _Pragma("unroll") for (int m = 0; m < 4; ++m) _Pragma("unroll") for (int n = 0; n < 2; ++n) {
                    int row = r0 + ai * 128 + m * 16, col = cbase + n * 4;
                    f32x4 g = acc[ai][0][m][n], u = acc[ai][1][m][n];
                    f32x4 r = {siluf_(g[0]) * u[0], siluf_(g[1]) * u[1], siluf_(g[2]) * u[2], siluf_(g[3]) * u[3]};
                    store_bf4(F1 + (size_t)row * DFF + col, r);
                  }
                });
    }
  }
  SYNC(8)
  PH(9) {
    u16* F2 = (u16*)(ws + WS_F2);
    float* acc9 = (float*)(ws + WS_ACC9);
    bool pre = false;
    for (int t = bid; t < 600; t += G) {
      if (t < 512) {
        int pm, pn; tile_map(t, 128, 4, pm, pn);
        GNext nx{(const u16*)(ws + WS_P1), (const u16*)(ws + WS_WF2), 0, 0, 0};
        if (t + G < 512) { int qm, qn; tile_map(t + G, 128, 4, qm, qn); nx.brow = qm * 256; nx.bcol = qn * 256; nx.valid = 1; }
        const bool pre_now = pre; pre = nx.valid;
        gemm_tile((const u16*)(ws + WS_P1), DFF, (const u16*)(ws + WS_WF2), DFF, DFF, pm * 256, pn * 256, pre_now, nx,
                  [&](AccRef acc, int r0, int c0) {
                    EPI_LOOP(ai, bj, m, n) {
                      int row = r0 + ai * 128 + m * 16, col = c0 + bj * 128 + n * 4;
                      store_bf4(F2 + (size_t)row * DM + col, acc[ai][bj][m][n]);
                    }
                  });
      } else {
        const int s2 = t - 512, tl = s2 / 11, ks = s2 % 11, pm = 128 + (tl >> 2), pn = tl & 3;
        gemm_tile((const u16*)(ws + WS_P1) + ks * 256, DFF, (const u16*)(ws + WS_WF2) + ks * 256, DFF, 256, pm * 256, pn * 256, false,
                  GNext{nullptr, nullptr, 0, 0, 0},
                  [&](AccRef acc, int r0, int c0) {
                    EPI_LOOP(ai, bj, m, n) {
                      int row = r0 + ai * 128 + m * 16 - TP, col = c0 + bj * 128 + n * 4;
                      float* d = acc9 + ((size_t)ks * TSMP + row) * DM + col;
                      f32x4 v = acc[ai][bj][m][n];
                      *(float4*)d = make_float4(v[0], v[1], v[2], v[3]);
                    }
                  });
        pre = false;
      }
    }
  }
  SYNC(9)
  PH(10) rowpass2(p);
}

extern "C" void kernel_launch(void* const* d_in, const int* in_sizes, int n_in, void* d_out, int out_size, void* d_ws,
                              size_t ws_size, hipStream_t stream) {
  static int grid_blocks = 0;
  if (grid_blocks == 0) {
    if (n_in != 25 || (size_t)out_size != OUT_TOTAL || ws_size < WS_END) {
      fprintf(stderr, "kernel_launch: unexpected sizes n_in=%d out=%d ws=%zu (need %zu)\n", n_in, out_size, ws_size, (size_t)WS_END);
      grid_blocks = -1;
      return;
    }
    int dev = 0, cus = 0, per_cu = 0;
    hipGetDevice(&dev);
    hipDeviceGetAttribute(&cus, hipDeviceAttributeMultiprocessorCount, dev);
    hipFuncSetAttribute((const void*)fwd_megakernel, hipFuncAttributeMaxDynamicSharedMemorySize, LDS_BYTES);
    hipOccupancyMaxActiveBlocksPerMultiprocessor(&per_cu, (const void*)fwd_megakernel, 512, LDS_BYTES);
    if (per_cu < 1) { fprintf(stderr, "kernel_launch: occupancy query says 0 blocks per CU\n"); grid_blocks = -1; return; }
    grid_blocks = cus * 1;
  }
  if (grid_blocks < 0) return;
  Params p{};
  const float** pp = (const float**)&p;
  for (int i = 0; i < 25; ++i) pp[i] = (const float*)d_in[i];
  p.out = (float*)d_out;
  p.ws = (char*)d_ws;
#if N_LAUNCH_MODE == 1
#ifndef MAX_PH
#define MAX_PH 11
#endif
  p.ph_lo = 0; p.ph_hi = MAX_PH;
  void* args[] = {&p};
  hipError_t e = hipLaunchCooperativeKernel((const void*)fwd_megakernel, dim3(grid_blocks), dim3(512), args, LDS_BYTES, stream);
  if (e != hipSuccess) fprintf(stderr, "cooperative launch failed: %s (grid %d)\n", hipGetErrorString(e), grid_blocks);
#else
  for (int ph = 0; ph < 11; ++ph) {
    p.ph_lo = ph; p.ph_hi = ph + 1;
    hipLaunchKernelGGL(fwd_megakernel, dim3(grid_blocks), dim3(512), LDS_BYTES, stream, p);
  }
#endif
}
```
